# Optimizing an MI355X kernel written in HIP

```python
import jax, jax.numpy as jnp
from jax import lax
import numpy as np

D_MODEL = 2048
BATCH = 1
SEQ = 8192
DEPTH = 1

D_MIX = D_MODEL
D_LRU = D_MIX // 2
D_RET = D_MIX - D_LRU
LRU_BLOCKS = 8
LRU_BLOCK_W = D_LRU // LRU_BLOCKS
CONV_W = 4
LRU_C = 8.0
RET_HEADS = 8
RET_HD = D_RET // RET_HEADS
CHUNK = 128
ROPE_BASE = 10000.0
D_FF = ((8 * D_MODEL + 3 * 256 - 1) // (3 * 256)) * 256
EPS = 1e-6
SPLITS = (D_LRU, 2 * D_LRU, 2 * D_LRU + D_RET, 2 * D_LRU + 2 * D_RET, 2 * D_LRU + 3 * D_RET)
D_IN = 2 * D_LRU + 4 * D_RET

kernel_name = "hymba_rglru_retention_hybrid"


def rmsnorm(x, w):
    xf = x.astype(jnp.float32)
    y = xf * lax.rsqrt(jnp.mean(xf * xf, axis=-1, keepdims=True) + EPS)
    return (y * w.astype(jnp.float32)).astype(x.dtype)


def causal_depthwise_conv(x, w, b):
    S = x.shape[1]
    xp = jnp.pad(x, ((0, 0), (CONV_W - 1, 0), (0, 0)))
    y = b
    for tap in range(CONV_W):
        y = y + xp[:, tap:tap + S, :] * w[tap]
    return y


def rg_lru(u, wa, ba, wx, bx, lam):
    B, S, _ = u.shape
    uf = u.astype(jnp.float32)
    ub = uf.reshape(B, S, LRU_BLOCKS, LRU_BLOCK_W)
    r = jax.nn.sigmoid(jnp.einsum('bsnc,ncd->bsnd', ub, wa.astype(jnp.float32)).reshape(B, S, D_LRU) + ba)
    i = jax.nn.sigmoid(jnp.einsum('bsnc,ncd->bsnd', ub, wx.astype(jnp.float32)).reshape(B, S, D_LRU) + bx)
    log_a = LRU_C * r * jax.nn.log_sigmoid(lam.astype(jnp.float32))
    a = jnp.exp(log_a)
    b = jnp.sqrt(-jnp.expm1(2.0 * log_a)) * (i * uf)

    def combine(left, right):
        a1, b1 = left
        a2, b2 = right
        return a1 * a2, a2 * b1 + b2

    _, h = lax.associative_scan(combine, (a, b), axis=1)
    return h.astype(u.dtype)


def rope(t, cos, sin):
    half = t.shape[-1] // 2
    t1, t2 = t[..., :half], t[..., half:]
    c = cos[None, :, None, :]
    s = sin[None, :, None, :]
    return jnp.concatenate([t1 * c - t2 * s, t1 * s + t2 * c], axis=-1)


def retention(q, k, v, g, gn_w):
    B, S, _ = q.shape
    H, Dh, C = RET_HEADS, RET_HD, CHUNK
    N = S // C
    f32 = jnp.float32
    pos = jnp.arange(S, dtype=f32)
    inv_freq = ROPE_BASE ** (-jnp.arange(0, Dh, 2, dtype=f32) / Dh)
    ang = pos[:, None] * inv_freq[None, :]
    cos, sin = jnp.cos(ang), jnp.sin(ang)
    qh = rope(q.astype(f32).reshape(B, S, H, Dh), cos, sin)
    kh = rope(k.astype(f32).reshape(B, S, H, Dh), cos, sin) * (Dh ** -0.5)
    vh = v.astype(f32).reshape(B, S, H, Dh)
    qc = qh.reshape(B, N, C, H, Dh)
    kc = kh.reshape(B, N, C, H, Dh)
    vc = vh.reshape(B, N, C, H, Dh)

    log_gamma = jnp.log1p(-jnp.exp2(-5.0 - jnp.arange(H, dtype=f32)))
    idx = jnp.arange(C)
    diff = idx[:, None] - idx[None, :]
    causal = diff >= 0
    decay = jnp.where(causal[None], jnp.exp(log_gamma[:, None, None] * jnp.where(causal, diff, 0)[None].astype(f32)), 0.0)

    scores = jnp.einsum('bnqhd,bnkhd->bnhqk', qc, kc) * decay[None, None]
    inner = jnp.einsum('bnhqk,bnkhe->bnqhe', scores, vc)

    zeta = jnp.exp(log_gamma[None, :] * (C - 1 - idx).astype(f32)[:, None])
    kv = jnp.einsum('bnkhd,bnkhe->bnhde', kc * zeta[:, :, None], vc)
    chunk_decay = jnp.exp(log_gamma * C)[:, None, None]

    def step(R, kv_n):
        return R * chunk_decay + kv_n, R

    _, R_prev = lax.scan(step, jnp.zeros((B, H, Dh, Dh), f32), jnp.moveaxis(kv, 1, 0))
    R_prev = jnp.moveaxis(R_prev, 0, 1)

    xi = jnp.exp(log_gamma[None, :] * (idx + 1).astype(f32)[:, None])
    cross = jnp.einsum('bnqhd,bnhde->bnqhe', qc * xi[:, :, None], R_prev)
    o = (inner + cross).reshape(B, S, H, Dh)

    mu = jnp.mean(o, axis=-1, keepdims=True)
    var = jnp.mean(jnp.square(o - mu), axis=-1, keepdims=True)
    on = ((o - mu) * lax.rsqrt(var + EPS)).reshape(B, S, D_RET) * gn_w.astype(f32)
    return (jax.nn.silu(g.astype(f32)) * on).astype(q.dtype)


def setup_inputs(seed: int = 0) -> dict:
    key = jax.random.key(seed)
    ks = jax.random.split(key, 20)
    f32 = jnp.float32

    def nrm(k, shape, scale):
        return jax.random.normal(k, shape, f32) * scale

    u = jax.random.uniform(ks[8], (DEPTH, D_LRU), f32, 0.9, 0.999)
    s = u ** (1.0 / LRU_C)
    lru_lambda = jnp.log(s) - jnp.log1p(-s)
    return {
        "x": nrm(ks[0], (BATCH, SEQ, D_MODEL), 1.0),
        "ln1_w": 1.0 + nrm(ks[1], (DEPTH, D_MODEL), 0.02),
        "w_in": nrm(ks[2], (DEPTH, D_MODEL, D_IN), D_MODEL ** -0.5),
        "conv_w": nrm(ks[3], (DEPTH, CONV_W, D_LRU), CONV_W ** -0.5),
        "conv_b": nrm(ks[4], (DEPTH, D_LRU), 0.01),
        "gate_a_w": nrm(ks[5], (DEPTH, LRU_BLOCKS, LRU_BLOCK_W, LRU_BLOCK_W), LRU_BLOCK_W ** -0.5),
        "gate_a_b": nrm(ks[6], (DEPTH, D_LRU), 0.01),
        "gate_x_w": nrm(ks[7], (DEPTH, LRU_BLOCKS, LRU_BLOCK_W, LRU_BLOCK_W), LRU_BLOCK_W ** -0.5),
        "gate_x_b": nrm(ks[9], (DEPTH, D_LRU), 0.01),
        "lru_lambda": lru_lambda,
        "ret_gn_w": 1.0 + nrm(ks[10], (DEPTH, D_RET), 0.02),
        "w_out": nrm(ks[11], (DEPTH, D_MIX, D_MODEL), D_MIX ** -0.5),
        "ln2_w": 1.0 + nrm(ks[12], (DEPTH, D_MODEL), 0.02),
        "w_ffn_gate": nrm(ks[13], (DEPTH, D_MODEL, D_FF), D_MODEL ** -0.5),
        "w_ffn_up": nrm(ks[14], (DEPTH, D_MODEL, D_FF), D_MODEL ** -0.5),
        "w_ffn_down": nrm(ks[15], (DEPTH, D_FF, D_MODEL), D_FF ** -0.5),
        "final_norm_w": 1.0 + nrm(ks[16], (D_MODEL,), 0.02),
    }


def reference(x, ln1_w, w_in, conv_w, conv_b, gate_a_w, gate_a_b, gate_x_w, gate_x_b,
              lru_lambda, ret_gn_w, w_out, ln2_w, w_ffn_gate, w_ffn_up, w_ffn_down, final_norm_w):
    h = x
    for l in range(DEPTH):
        u = rmsnorm(h, ln1_w[l])
        proj = jnp.einsum('bsd,de->bse', u, w_in[l])
        lru_x, lru_g, q, k, v, ret_g = jnp.split(proj, SPLITS, axis=-1)
        lru_x = causal_depthwise_conv(lru_x, conv_w[l], conv_b[l])
        y_lru = rg_lru(lru_x, gate_a_w[l], gate_a_b[l], gate_x_w[l], gate_x_b[l], lru_lambda[l])
        y_lru = y_lru * jax.nn.gelu(lru_g)
        y_ret = retention(q, k, v, ret_g, ret_gn_w[l])
        y = jnp.concatenate([y_lru, y_ret], axis=-1)
        h = h + jnp.einsum('bse,ed->bsd', y, w_out[l])
        u = rmsnorm(h, ln2_w[l])
        ff = jax.nn.silu(jnp.einsum('bsd,df->bsf', u, w_ffn_gate[l])) * jnp.einsum('bsd,df->bsf', u, w_ffn_up[l])
        h = h + jnp.einsum('bsf,fd->bsd', ff, w_ffn_down[l])
    return rmsnorm(h, final_norm_w)
```

```cpp
#include <hip/hip_runtime.h>
#include <hip/hip_cooperative_groups.h>
#include <cstdio>
#include <cstdint>
namespace cg = cooperative_groups;

#ifndef REP_MASK
#define REP_MASK 0
#endif
#ifndef MK_ONE_LAUNCH
#define MK_ONE_LAUNCH 1
#endif

#define LAS __attribute__((address_space(3)))
typedef unsigned short bf16_t;
typedef short bf16x8 __attribute__((ext_vector_type(8)));
typedef float f32x4 __attribute__((ext_vector_type(4)));
typedef float f32x2 __attribute__((ext_vector_type(2)));
typedef unsigned u32x4 __attribute__((ext_vector_type(4)));
typedef unsigned u32x2 __attribute__((ext_vector_type(2)));

constexpr int S_ = 8192, D_ = 2048, DIN = 6144, DLRU = 1024, DRET = 1024, DFF = 5632, NGU = 2 * DFF;
constexpr int NWAVES = 8, NTHR = 512;
constexpr float EPS = 1e-6f;
constexpr int LCH = 64;
constexpr int NLCH = S_ / LCH;
constexpr int RCH = 128, NRCH = S_ / RCH;
constexpr size_t MiB = 1u << 20;
constexpr size_t WS_RSTD1 = 0, WS_SS2 = 64 * 1024, WS_SS3 = 320 * 1024, WS_GAT = 576 * 1024, WS_GXT = 832 * 1024,
                 WS_ATOT = 1088 * 1024, WS_HEND = 1600 * 1024, WS_CARRY = 2112 * 1024;
constexpr size_t WS_ROPEC = 4 * MiB, WS_ROPES = 6 * MiB;
constexpr size_t WS_WOUT = 8 * MiB, WS_WGU = 16 * MiB, WS_WD = 60 * MiB, WS_PROJ = 82 * MiB;
constexpr size_t WS_WIN = 178 * MiB, WS_XB = 202 * MiB;
constexpr size_t WS_KV = 178 * MiB, WS_RP = 210 * MiB;
constexpr size_t WS_Y = 226 * MiB;
constexpr size_t WS_H1B = 82 * MiB, WS_FF = 114 * MiB;
constexpr size_t WS_END = 258 * MiB;
constexpr size_t WS_BAR = 2688 * 1024;
constexpr size_t WS_PCNT = WS_BAR + 16 * 1024;
constexpr size_t CTL_ZERO_BYTES = 16 * 1024 + 32 * 256 + 256;
constexpr int LDS_CTL = 163840 - 256;
constexpr int LDS_BYTES = 163840;

__device__ __forceinline__ unsigned pk2(float lo, float hi) { unsigned r; asm volatile("v_cvt_pk_bf16_f32 %0, %1, %2" : "=v"(r) : "v"(lo), "v"(hi)); return r; }
__device__ __forceinline__ unsigned pk2_sw(float lo, float hi) { unsigned a = __float_as_uint(lo), b = __float_as_uint(hi); a += 0x7fffu + ((a >> 16) & 1u); b += 0x7fffu + ((b >> 16) & 1u); return (a >> 16) | (b & 0xffff0000u); }
__device__ __forceinline__ float bf_lo(unsigned w) { return __uint_as_float(w << 16); }
__device__ __forceinline__ float bf_hi(unsigned w) { return __uint_as_float(w & 0xffff0000u); }
__device__ __forceinline__ float sigm(float z) { return __builtin_amdgcn_rcpf(1.f + __builtin_amdgcn_exp2f(-1.4426950408889634f * z)); }
__device__ __forceinline__ float wave_sum(float v) {
#pragma unroll
    for (int o = 1; o < 64; o <<= 1) v += __shfl_xor(v, o);
    return v;
}

namespace pg8 {
constexpr int BM = 256, BK = 64, HALF = 128, HTB = HALF * BK * 2, STAGE_BYTES = 8 * HTB, NXCD = 8, WGM = 8;
__host__ __device__ __forceinline__ int lds_byte(int r, int c) { const int st = (r >> 4) * 2 + (c >> 5), rr = r & 15, cc = c & 31, ob = rr * 64 + cc * 2; return st * 1024 + (ob ^ (((ob >> 9) & 1) << 5)); }
__host__ __device__ __forceinline__ void stage_rc(int b, int& R, int& C) { const int st = b / 1024, sb = b % 1024, swz = sb ^ (((sb >> 9) & 1) << 5); R = (st >> 1) * 16 + swz / 64; C = (st & 1) * 32 + (swz % 64) / 2; }
__host__ __device__ __forceinline__ int perm32(int rho) { const int n = rho >> 4, i = rho & 15; return 8 * (i >> 2) + 4 * n + (i & 3); }
struct Unit { int pm, pn; };
struct Gemm { const bf16_t* A; const bf16_t* Bt; int M, N, K; };
struct StaticOrder {
    int nM, nN, nwg, G, c;
    __host__ __device__ void init(int M, int N, int G_, int c_) { nM = M / BM; nN = N / BM; nwg = nM * nN; G = G_; c = c_; }
    __host__ __device__ bool next(int i, Unit& u) const {
        const long L = (long)i * G + c; if (L >= nwg) return false;
        int wgid = (int)L; { const int q = nwg / NXCD, r = nwg % NXCD, xcd = wgid % NXCD, off = wgid / NXCD; wgid = (xcd < r ? xcd * (q + 1) : r * (q + 1) + (xcd - r) * q) + off; }
        const int nig = WGM * nN, gid = wgid / nig, fm = gid * WGM, gsz = (nM - fm) < WGM ? (nM - fm) : WGM;
        u.pm = fm + ((wgid % nig) % gsz); u.pn = (wgid % nig) / gsz; return true;
    }
};

struct EpiProj {
    static constexpr bool PERM = true, AFTER_DRAIN = false;
    bf16_t* O; int ldc; const float* rs;
    __device__ __forceinline__ void operator()(const f32x4 (&acc)[2][2][4][2], const Unit& u, int wr, int wc, int fr, int fq) const {
        const int row0 = u.pm * BM + wr * 64 + fr, col0 = u.pn * BM + wc * 32 + 8 * fq;
#pragma unroll
        for (int ai = 0; ai < 2; ++ai)
#pragma unroll
            for (int m = 0; m < 4; ++m) { const int r = row0 + ai * HALF + m * 16; const float s = rs[r]; bf16_t* rowp = O + (size_t)r * ldc + col0;
#pragma unroll
                for (int bj = 0; bj < 2; ++bj) { const f32x4 v0 = acc[ai][bj][m][0] * s, v1 = acc[ai][bj][m][1] * s;
                    u32x4 w; w.x = pk2(v0[0], v0[1]); w.y = pk2(v0[2], v0[3]); w.z = pk2(v1[0], v1[1]); w.w = pk2(v1[2], v1[3]);
                    *(u32x4*)(rowp + bj * HALF) = w; } }
    }
};
struct EpiSwiglu {
    static constexpr bool PERM = true, AFTER_DRAIN = false;
    bf16_t* O; int ldc; const float* ss;
    __device__ __forceinline__ void operator()(const f32x4 (&acc)[2][2][4][2], const Unit& u, int wr, int wc, int fr, int fq) const {
        const int row0 = u.pm * BM + wr * 64 + fr, col0 = u.pn * HALF + wc * 32 + 8 * fq;
#pragma unroll
        for (int ai = 0; ai < 2; ++ai)
#pragma unroll
            for (int m = 0; m < 4; ++m) { const int r = row0 + ai * HALF + m * 16;
                const f32x4 p0 = *(const f32x4*)(ss + (size_t)r * 8), p1 = *(const f32x4*)(ss + (size_t)r * 8 + 4);
                const float tot = ((p0[0] + p0[1]) + (p0[2] + p0[3])) + ((p1[0] + p1[1]) + (p1[2] + p1[3]));
                const float s = __builtin_amdgcn_rsqf(tot * (1.0f / D_) + EPS);
                float o[8];
#pragma unroll
                for (int n = 0; n < 2; ++n)
#pragma unroll
                    for (int j = 0; j < 4; ++j) { const float g = acc[ai][0][m][n][j] * s, up = acc[ai][1][m][n][j] * s; o[n * 4 + j] = g * sigm(g) * up; }
                u32x4 w; w.x = pk2(o[0], o[1]); w.y = pk2(o[2], o[3]); w.z = pk2(o[4], o[5]); w.w = pk2(o[6], o[7]);
                *(u32x4*)(O + (size_t)r * ldc + col0) = w; }
    }
};
struct EpiNull { static constexpr bool PERM = true, AFTER_DRAIN = false; float* sink;
    __device__ __forceinline__ void operator()(const f32x4 (&acc)[2][2][4][2], const Unit& u, int wr, int wc, int fr, int fq) const { if (acc[0][0][0][0][0] == 123.456f) sink[0] = 1.f; } };
struct EpiResid {
    static constexpr bool PERM = true, AFTER_DRAIN = true;
    const bf16_t* base; float* out; bf16_t* ob; int ldc; float* ss;
    __device__ __forceinline__ void fused(f32x4 (&acc)[2][2][4][2], const Unit& u, int wr, int wc, int fr, int fq, LAS unsigned char* lds, int wid, int lane) const {
        LAS float* P = (LAS float*)lds;
        const int col0 = u.pn * BM + wc * 32 + 8 * fq;
#pragma unroll
        for (int ai = 0; ai < 2; ++ai)
#pragma unroll
            for (int m = 0; m < 4; ++m) { const int rl = ai * HALF + wr * 64 + m * 16 + fr; const size_t off = (size_t)(u.pm * BM + rl) * ldc + col0; float q = 0.f;
#pragma unroll
                for (int bj = 0; bj < 2; ++bj) {
                    const u32x4 bw = *(const u32x4*)(base + off + bj * HALF);
                    const f32x4 b0 = (f32x4){bf_lo(bw.x), bf_hi(bw.x), bf_lo(bw.y), bf_hi(bw.y)}, b1 = (f32x4){bf_lo(bw.z), bf_hi(bw.z), bf_lo(bw.w), bf_hi(bw.w)};
                    const f32x4 v0 = acc[ai][bj][m][0] + b0, v1 = acc[ai][bj][m][1] + b1;
                    if (out) { *(f32x4*)(out + off + bj * HALF) = v0; *(f32x4*)(out + off + bj * HALF + 4) = v1; }
                    if (ob) { u32x4 w; w.x = pk2(v0[0], v0[1]); w.y = pk2(v0[2], v0[3]); w.z = pk2(v1[0], v1[1]); w.w = pk2(v1[2], v1[3]); *(u32x4*)(ob + off + bj * HALF) = w; }
                    q += (v0[0] * v0[0] + v0[1] * v0[1]) + (v0[2] * v0[2] + v0[3] * v0[3]) + (v1[0] * v1[0] + v1[1] * v1[1]) + (v1[2] * v1[2] + v1[3] * v1[3]); }
                q += __shfl_xor(q, 16); q += __shfl_xor(q, 32);
                if (fq == 0) P[rl * 4 + wc] = q;
                if (m & 1) asm volatile("" ::: "memory"); }
        __syncthreads();
        const int t = wid * 64 + lane;
        if (t < 256) { const f32x4 p = *(const LAS f32x4*)(P + t * 4); ss[(size_t)(u.pm * BM + t) * 8 + u.pn] = (p[0] + p[1]) + (p[2] + p[3]); }
        __syncthreads();
    }
};

struct EpiFinal {
    static constexpr bool PERM = true, AFTER_DRAIN = true;
    const bf16_t* base; float* out; int ldc; float* ss; unsigned* cnt; const float* w; unsigned* tmo;
    __device__ __forceinline__ void fused(f32x4 (&acc)[2][2][4][2], const Unit& u, int wr, int wc, int fr, int fq, LAS unsigned char* lds, int wid, int lane) const {
        LAS float* P = (LAS float*)lds;
        LAS float* R = (LAS float*)(lds + 4096);
        const int col0 = u.pn * BM + wc * 32 + 8 * fq;
#pragma unroll
        for (int ai = 0; ai < 2; ++ai)
#pragma unroll
            for (int m = 0; m < 4; ++m) { const int rl = ai * HALF + wr * 64 + m * 16 + fr; const size_t off = (size_t)(u.pm * BM + rl) * ldc + col0; float q = 0.f;
#pragma unroll
                for (int bj = 0; bj < 2; ++bj) {
                    const u32x4 bw = *(const u32x4*)(base + off + bj * HALF);
                    const f32x4 b0 = (f32x4){bf_lo(bw.x), bf_hi(bw.x), bf_lo(bw.y), bf_hi(bw.y)}, b1 = (f32x4){bf_lo(bw.z), bf_hi(bw.z), bf_lo(bw.w), bf_hi(bw.w)};
                    const f32x4 v0 = acc[ai][bj][m][0] + b0, v1 = acc[ai][bj][m][1] + b1;
                    acc[ai][bj][m][0] = v0; acc[ai][bj][m][1] = v1;
                    q += (v0[0] * v0[0] + v0[1] * v0[1]) + (v0[2] * v0[2] + v0[3] * v0[3]) + (v1[0] * v1[0] + v1[1] * v1[1]) + (v1[2] * v1[2] + v1[3] * v1[3]); }
                q += __shfl_xor(q, 16); q += __shfl_xor(q, 32);
                if (fq == 0) P[rl * 4 + wc] = q;
                if (m & 1) asm volatile("" ::: "memory"); }
        __syncthreads();
        const int t = wid * 64 + lane;
        unsigned* pc = cnt + 64 * u.pm;
        if (t < 256) { const f32x4 p = *(const LAS f32x4*)(P + t * 4);
            __hip_atomic_store(ss + (size_t)(u.pm * BM + t) * 8 + u.pn, (p[0] + p[1]) + (p[2] + p[3]), __ATOMIC_RELAXED, __HIP_MEMORY_SCOPE_AGENT);
            asm volatile("s_waitcnt vmcnt(0)" ::: "memory");
            if (lane == 0) __hip_atomic_fetch_add(pc, 1u, __ATOMIC_RELAXED, __HIP_MEMORY_SCOPE_AGENT); }
        if (wid == 0) {
            unsigned sp = 0;
            while ((unsigned)__builtin_amdgcn_readfirstlane(__hip_atomic_load(pc, __ATOMIC_RELAXED, __HIP_MEMORY_SCOPE_AGENT)) < 32u) {
                __builtin_amdgcn_s_sleep(2);
                if (++sp > (1u << 22)) { if (lane == 0) __hip_atomic_store(tmo, 1u, __ATOMIC_RELAXED, __HIP_MEMORY_SCOPE_AGENT); break; } }
            __builtin_amdgcn_fence(__ATOMIC_ACQUIRE, "agent");
            asm volatile("s_waitcnt vmcnt(0)" ::: "memory");
        }
        __syncthreads();
        if (t < 256) { const float* sp8 = ss + (size_t)(u.pm * BM + t) * 8; float tot = 0.f;
#pragma unroll
            for (int j = 0; j < 8; ++j) tot += __hip_atomic_load(sp8 + j, __ATOMIC_RELAXED, __HIP_MEMORY_SCOPE_AGENT);
            R[t] = 1.0f / sqrtf(tot * (1.0f / D_) + EPS); }
        __syncthreads();
        f32x4 wv[2][2];
#pragma unroll
        for (int bj = 0; bj < 2; ++bj) { wv[bj][0] = *(const f32x4*)(w + col0 + bj * HALF); wv[bj][1] = *(const f32x4*)(w + col0 + bj * HALF + 4); }
#pragma unroll
        for (int ai = 0; ai < 2; ++ai)
#pragma unroll
            for (int m = 0; m < 4; ++m) { const int rl = ai * HALF + wr * 64 + m * 16 + fr; const size_t off = (size_t)(u.pm * BM + rl) * ldc + col0; const float rs = R[rl];
#pragma unroll
                for (int bj = 0; bj < 2; ++bj) { *(f32x4*)(out + off + bj * HALF) = acc[ai][bj][m][0] * rs * wv[bj][0]; *(f32x4*)(out + off + bj * HALF + 4) = acc[ai][bj][m][1] * rs * wv[bj][1]; } }
        __syncthreads();
    }
};

template <class Epi, class Sched, bool ALIGN_EPI = false, bool SP2 = false>
__device__ __forceinline__ void gemm_phase(LAS unsigned char* lds, const Gemm g, const Sched& S, const Epi& E) {
    const int tid = threadIdx.x, wid = __builtin_amdgcn_readfirstlane(tid >> 6), lane = tid & 63, wr = wid >> 2, wc = wid & 3, fr = lane & 15, fq = lane >> 4;
    const int K = g.K, nt = K / BK;
    unsigned voffA[2], voffB[2];
#pragma unroll
    for (int i = 0; i < 2; ++i) { int R, C; stage_rc(tid * 16 + i * 8192, R, C); const int Rb = Epi::PERM ? ((R & ~31) + perm32(R & 31)) : R;
        voffA[i] = (unsigned)(R * K + C) * 2u; voffB[i] = (unsigned)(Rb * K + C) * 2u; }
    const size_t kstep = (size_t)(BK * 2);
    const size_t hstep = (size_t)HALF * K * 2;
    const size_t tstep = 2 * hstep;
    const unsigned ldsw = (unsigned)wid * 1024u;
    const int aoff = lds_byte(wr * 64 + fr, fq * 8), boff = lds_byte(wc * 32 + fr, fq * 8);
#define PG8_SA(b, h) (((b) * 2 + (h)) * HTB)
#define PG8_SB(b, h) ((4 + (b) * 2 + (h)) * HTB)
#define PG8_STAGE(bufoff, gbase, voff) do { _Pragma("unroll") for (int _i = 0; _i < 2; ++_i) \
        __builtin_amdgcn_global_load_lds((const unsigned*)((const char*)(gbase) + (voff)[_i]), (LAS unsigned*)(lds + (bufoff) + ldsw + _i * 8192), 16, 0, 0); } while (0)
#define PG8_LDA(dst, b, h) do { _Pragma("unroll") for (int m = 0; m < 4; ++m) _Pragma("unroll") for (int k = 0; k < 2; ++k) dst[m][k] = *(const LAS bf16x8*)(lds + PG8_SA(b, h) + aoff + m * 2048 + k * 1024); } while (0)
#define PG8_LDB(dst, b, h) do { _Pragma("unroll") for (int n = 0; n < 2; ++n) _Pragma("unroll") for (int k = 0; k < 2; ++k) dst[n][k] = *(const LAS bf16x8*)(lds + PG8_SB(b, h) + boff + n * 2048 + k * 1024); } while (0)
#define PG8_MMA(ai, bj, At, Bt) do { __builtin_amdgcn_s_setprio(1); _Pragma("unroll") for (int m = 0; m < 4; ++m) _Pragma("unroll") for (int n = 0; n < 2; ++n) _Pragma("unroll") for (int k = 0; k < 2; ++k) \
        acc[ai][bj][m][n] = __builtin_amdgcn_mfma_f32_16x16x32_bf16(Bt[n][k], At[m][k], acc[ai][bj][m][n], 0, 0, 0); __builtin_amdgcn_s_setprio(0); } while (0)
#define PG8_WAIT_V(n) asm volatile("s_waitcnt vmcnt(" #n ")" ::: "memory")
#define PG8_WAIT_L(n) asm volatile("s_waitcnt lgkmcnt(" #n ")" ::: "memory")
#define PG8_BAR __builtin_amdgcn_s_barrier()
#define PG8_SCHED __builtin_amdgcn_sched_barrier(0)
    Unit cur, nxt; int ui = 0;
    if (!S.next(0, cur)) return;
    f32x4 acc[2][2][4][2];
#pragma unroll
    for (int a = 0; a < 2; ++a)
#pragma unroll
        for (int b = 0; b < 2; ++b)
#pragma unroll
            for (int m = 0; m < 4; ++m)
#pragma unroll
                for (int n = 0; n < 2; ++n) acc[a][b][m][n] = (f32x4){0.f, 0.f, 0.f, 0.f};
    bf16x8 At[4][2], B0[2][2], B1[2][2];
    const char* cA = (const char*)g.A + (size_t)cur.pm * tstep; const char* cB = (const char*)g.Bt + (size_t)cur.pn * tstep;
    if constexpr (SP2) {
        PG8_STAGE(PG8_SB(0, 0), cB, voffB); PG8_STAGE(PG8_SB(0, 1), cB + hstep, voffB); PG8_STAGE(PG8_SA(0, 0), cA, voffA); PG8_STAGE(PG8_SA(0, 1), cA + hstep, voffA);
        if (wr == 1) PG8_BAR;
        PG8_WAIT_V(2); PG8_BAR;
        PG8_STAGE(PG8_SB(1, 0), cB + kstep, voffB); PG8_STAGE(PG8_SA(1, 0), cA + kstep, voffA); PG8_STAGE(PG8_SB(1, 1), cB + hstep + kstep, voffB);
        PG8_WAIT_V(6); PG8_BAR;
    } else {
        PG8_STAGE(PG8_SB(0, 0), cB, voffB); PG8_STAGE(PG8_SA(0, 0), cA, voffA); PG8_STAGE(PG8_SB(0, 1), cB + hstep, voffB); PG8_STAGE(PG8_SA(0, 1), cA + hstep, voffA);
        if (wr == 1) PG8_BAR;
        PG8_WAIT_V(4); PG8_BAR;
        PG8_STAGE(PG8_SB(1, 0), cB + kstep, voffB); PG8_STAGE(PG8_SA(1, 0), cA + kstep, voffA); PG8_STAGE(PG8_SB(1, 1), cB + hstep + kstep, voffB);
        PG8_WAIT_V(6); PG8_BAR;
    }
    for (;;) {
        const bool has_next = S.next(ui + 1, nxt);
        const char* nA = has_next ? (const char*)g.A + (size_t)nxt.pm * tstep : cA; const char* nB = has_next ? (const char*)g.Bt + (size_t)nxt.pn * tstep : cB;
        for (int t = 0; t < nt; t += 2) {
            const bool last = (t == nt - 2);
            const char* a1 = cA + (size_t)(t + 1) * kstep;
            const char* a2 = last ? nA : cA + (size_t)(t + 2) * kstep; const char* b2 = last ? nB : cB + (size_t)(t + 2) * kstep;
            const char* a3 = a2 + kstep; const char* b3 = b2 + kstep;
            if constexpr (SP2) {
            PG8_LDB(B0, 0, 0); PG8_LDB(B1, 0, 1); PG8_SCHED; PG8_LDA(At, 0, 0); PG8_STAGE(PG8_SA(1, 1), a1 + hstep, voffA);
            PG8_WAIT_V(8); PG8_WAIT_L(0); PG8_BAR; PG8_MMA(0, 0, At, B0); PG8_MMA(0, 1, At, B1); PG8_BAR; PG8_SCHED;
            PG8_LDA(At, 0, 1); PG8_STAGE(PG8_SB(0, 0), b2, voffB); PG8_STAGE(PG8_SB(0, 1), b2 + hstep, voffB); PG8_STAGE(PG8_SA(0, 0), a2, voffA);
            PG8_WAIT_V(8); PG8_WAIT_L(0); PG8_BAR; PG8_MMA(1, 0, At, B0); PG8_MMA(1, 1, At, B1); PG8_BAR; PG8_SCHED;
            PG8_LDB(B0, 1, 0); PG8_LDB(B1, 1, 1); PG8_SCHED; PG8_LDA(At, 1, 0); PG8_STAGE(PG8_SA(0, 1), a2 + hstep, voffA);
            PG8_WAIT_V(8); PG8_WAIT_L(0); PG8_BAR; PG8_MMA(0, 0, At, B0); PG8_MMA(0, 1, At, B1); PG8_BAR; PG8_SCHED;
            PG8_LDA(At, 1, 1); PG8_STAGE(PG8_SB(1, 0), b3, voffB); PG8_STAGE(PG8_SB(1, 1), b3 + hstep, voffB); PG8_STAGE(PG8_SA(1, 0), a3, voffA);
            PG8_WAIT_V(8); PG8_WAIT_L(0); PG8_BAR; PG8_MMA(1, 0, At, B0); PG8_MMA(1, 1, At, B1); PG8_BAR; PG8_SCHED;
            } else {
            PG8_LDB(B0, 0, 0); PG8_SCHED; PG8_LDA(At, 0, 0); PG8_STAGE(PG8_SA(1, 1), a1 + hstep, voffA);
            PG8_WAIT_L(8); PG8_BAR; PG8_WAIT_L(0); PG8_MMA(0, 0, At, B0); PG8_BAR; PG8_SCHED;
            PG8_LDB(B1, 0, 1); PG8_STAGE(PG8_SB(0, 0), b2, voffB);
            PG8_BAR; PG8_WAIT_L(0); PG8_MMA(0, 1, At, B1); PG8_BAR;
            PG8_LDA(At, 0, 1); PG8_STAGE(PG8_SA(0, 0), a2, voffA);
            PG8_BAR; PG8_WAIT_L(0); PG8_MMA(1, 0, At, B0); PG8_BAR; PG8_SCHED;
            PG8_STAGE(PG8_SB(0, 1), b2 + hstep, voffB);
            PG8_WAIT_V(6); PG8_BAR; PG8_MMA(1, 1, At, B1); PG8_BAR;
            PG8_LDB(B0, 1, 0); PG8_SCHED; PG8_LDA(At, 1, 0); PG8_STAGE(PG8_SA(0, 1), a2 + hstep, voffA);
            PG8_WAIT_L(8); PG8_BAR; PG8_WAIT_L(0); PG8_MMA(0, 0, At, B0); PG8_BAR; PG8_SCHED;
            PG8_LDB(B1, 1, 1); PG8_STAGE(PG8_SB(1, 0), b3, voffB);
            PG8_BAR; PG8_WAIT_L(0); PG8_MMA(0, 1, At, B1); PG8_BAR;
            PG8_LDA(At, 1, 1); PG8_STAGE(PG8_SA(1, 0), a3, voffA);
            PG8_BAR; PG8_WAIT_L(0); PG8_MMA(1, 0, At, B0); PG8_BAR; PG8_SCHED;
            PG8_STAGE(PG8_SB(1, 1), b3 + hstep, voffB);
            PG8_WAIT_V(6); PG8_BAR; PG8_MMA(1, 1, At, B1); PG8_BAR;
            }
        }
        if constexpr (ALIGN_EPI) { if (wr == 0) PG8_BAR; }
        if constexpr (!Epi::AFTER_DRAIN) { E(acc, cur, wr, wc, fr, fq); }
        if (!has_next) break;
#pragma unroll
        for (int a = 0; a < 2; ++a)
#pragma unroll
            for (int b = 0; b < 2; ++b)
#pragma unroll
                for (int m = 0; m < 4; ++m)
#pragma unroll
                    for (int n = 0; n < 2; ++n) acc[a][b][m][n] = (f32x4){0.f, 0.f, 0.f, 0.f};
        cur = nxt; cA = nA; cB = nB; ++ui;
        if constexpr (ALIGN_EPI) { if (wr == 1) PG8_BAR; }
    }
    PG8_WAIT_V(0);
    if constexpr (!ALIGN_EPI) { if (wr == 0) PG8_BAR; }
    PG8_BAR;
    if constexpr (Epi::AFTER_DRAIN) { E.fused(acc, cur, wr, wc, fr, fq, lds, wid, lane); }
#undef PG8_SA
#undef PG8_SB
#undef PG8_STAGE
#undef PG8_LDA
#undef PG8_LDB
#undef PG8_MMA
#undef PG8_WAIT_V
#undef PG8_WAIT_L
#undef PG8_BAR
#undef PG8_SCHED
}
}


#define XB_TMO      128
#define XB_XCNT(j)  (256  + 64 * (j))
#define XB_XSUB(j)  (1280 + 64 * (j))
#define XB_XGEN(j)  (2304 + 64 * (j))
#define XB_TOP      3328
#define XB_TOPGEN   3392
#define XCD_BAR_WORDS 3456
#define XB_SPIN_CAP (1u << 22)
__device__ __forceinline__ unsigned xb_ld(unsigned* p)              { return __hip_atomic_load(p, __ATOMIC_RELAXED, __HIP_MEMORY_SCOPE_AGENT); }
__device__ __forceinline__ unsigned xb_add(unsigned* p, unsigned v) { return __hip_atomic_fetch_add(p, v, __ATOMIC_RELAXED, __HIP_MEMORY_SCOPE_AGENT); }
__device__ __forceinline__ unsigned xb_xcc_id() { return (unsigned)__builtin_amdgcn_s_getreg((3 << 11) | 20) & 0xFu; }
#define XB_SPIN(cond, bar) do { unsigned _sp = 0; while (cond) { __builtin_amdgcn_s_sleep(1); \
    if ((++_sp & 255u) == 0u) { if (xb_ld(&(bar)[XB_TMO])) break; if (_sp > XB_SPIN_CAP) { atomicAdd(&(bar)[XB_TMO], 1u); break; } } } } while (0)
struct XcdBarrier { unsigned* bar; unsigned x; volatile LAS unsigned* st; };
__device__ __forceinline__ XcdBarrier xcd_barrier_post(unsigned* bar, volatile LAS unsigned* st) {
    XcdBarrier b; b.bar = bar; b.x = xb_xcc_id(); b.st = st;
    if (threadIdx.x == 0) (void)xb_add(&bar[XB_XCNT(b.x)], 1u);
    return b;
}
__device__ __forceinline__ void xcd_barrier_complete(unsigned* bar, unsigned x, unsigned& nloc, unsigned& nx) {
    const unsigned G = gridDim.x * gridDim.y * gridDim.z;
    unsigned sum, cnt, mine, sp = 0u;
    for (;;) {
        sum = 0u; cnt = 0u; mine = 0u;
#pragma unroll
        for (unsigned j = 0; j < 16; ++j) { const unsigned c = xb_ld(&bar[XB_XCNT(j)]); sum += c; cnt += (c > 0u) ? 1u : 0u; mine = (j == x) ? c : mine; }
        if (sum == G) break;
        __builtin_amdgcn_s_sleep(1);
        if ((++sp & 255u) == 0u) { if (xb_ld(&bar[XB_TMO])) break; if (sp > XB_SPIN_CAP) { atomicAdd(&bar[XB_TMO], 1u); break; } }
    }
    nloc = mine > 0u ? mine : 1u; nx = cnt > 0u ? cnt : 1u;
}
__device__ __forceinline__ void xcd_barrier(const XcdBarrier& b) {
    asm volatile("s_waitcnt vmcnt(0)" ::: "memory");
    __syncthreads();
    if (threadIdx.x == 0) {
        unsigned* bar = b.bar;
        __builtin_amdgcn_s_waitcnt(0);
        unsigned nloc = b.st[0], nx = b.st[1];
        if (nloc == 0u) { xcd_barrier_complete(bar, b.x, nloc, nx); b.st[0] = nloc; b.st[1] = nx; }
        const unsigned old = xb_add(&bar[XB_XSUB(b.x)], 1u);
        const unsigned gen = old / nloc;
        if (old + 1u == (gen + 1u) * nloc) {
            __builtin_amdgcn_fence(__ATOMIC_RELEASE, "agent");
            asm volatile("s_waitcnt vmcnt(0)" ::: "memory");
            const unsigned og = xb_add(&bar[XB_TOP], 1u);
            const unsigned tg = og / nx;
            if (og + 1u == (tg + 1u) * nx) xb_add(&bar[XB_TOPGEN], 1u);
            else XB_SPIN(xb_ld(&bar[XB_TOPGEN]) == tg, bar);
            __builtin_amdgcn_fence(__ATOMIC_ACQUIRE, "agent");
            xb_add(&bar[XB_XGEN(b.x)], 1u);
            asm volatile("s_waitcnt vmcnt(0)" ::: "memory");
        } else {
            XB_SPIN(xb_ld(&bar[XB_XGEN(b.x)]) == gen, bar);
            __builtin_amdgcn_fence(__ATOMIC_ACQUIRE, "agent");
            asm volatile("s_waitcnt vmcnt(0)" ::: "memory");
        }
    }
    __syncthreads();
}

struct Args { const float* in[17]; float* out; unsigned char* ws; int ph_lo, ph_hi; };
struct Ctx {
    LAS unsigned char* lds; int tid, lane, wave, G, bid;
    const float *x, *ln1, *w_in, *conv_w, *conv_b, *ga_w, *ga_b, *gx_w, *gx_b, *lam, *gn_w, *w_out, *ln2, *w_g, *w_u, *w_d, *fnw;
    float* out; unsigned char* ws;
};

struct TDesc { const float* W; bf16_t* WT; const float* ks; int K, N, mode, item; };
__device__ __forceinline__ void t_load(const TDesc& d, int lane, float (&v)[32], f32x4& s0, f32x4& s1) {
    const int nblk = d.N >> 5, kb = d.item / nblk, nb = d.item - kb * nblk, k0 = 64 * kb, n0 = 32 * nb;
    const float* p = d.W + (size_t)(k0 + (lane >> 5)) * d.N + n0 + (lane & 31);
    const size_t rs2 = (size_t)2 * d.N;
#pragma unroll
    for (int i = 0; i < 32; ++i) v[i] = p[i * rs2];
    s0 = (f32x4){1.f, 1.f, 1.f, 1.f}; s1 = s0;
    if (d.ks) { const float* kp = d.ks + k0 + 8 * (lane & 7); s0 = *(const f32x4*)kp; s1 = *(const f32x4*)(kp + 4); }
}
__device__ __forceinline__ void t_store(const TDesc& d, int lane, const float (&v)[32], const f32x4 s0, const f32x4 s1, LAS float* scr) {
    const int nblk = d.N >> 5, kb = d.item / nblk, nb = d.item - kb * nblk, k0 = 64 * kb, n0 = 32 * nb;
#pragma unroll
    for (int i = 0; i < 32; ++i) { const int kk = 2 * i + (lane >> 5); scr[kk * 33 + (lane & 31)] = v[i]; }
    asm volatile("s_waitcnt lgkmcnt(0)" ::: "memory");
    const int c = lane & 7;
#pragma unroll
    for (int j = 0; j < 4; ++j) { const int n = (lane >> 3) + 8 * j; const LAS float* s = scr + (8 * c) * 33 + n;
        u32x4 o; o.x = pk2(s[0 * 33] * s0[0], s[1 * 33] * s0[1]); o.y = pk2(s[2 * 33] * s0[2], s[3 * 33] * s0[3]); o.z = pk2(s[4 * 33] * s1[0], s[5 * 33] * s1[1]); o.w = pk2(s[6 * 33] * s1[2], s[7 * 33] * s1[3]);
        const int ng = n0 + n;
        int drow = ng;
        if (d.mode == 1) drow = (ng >> 7) * 256 + (ng & 127);
        else if (d.mode == 2) drow = (ng >> 7) * 256 + 128 + (ng & 127);
        *(u32x4*)(d.WT + (size_t)drow * d.K + k0 + 8 * c) = o; }
    asm volatile("s_waitcnt lgkmcnt(0)" ::: "memory");
}
__device__ __forceinline__ bool p0_desc(const Ctx& F, int part, int it, TDesc& d) {
    constexpr int I_IN = (D_ / 64) * (DIN / 32), I_OUT = (D_ / 64) * (D_ / 32), I_G = (D_ / 64) * (DFF / 32), I_D = (DFF / 64) * (D_ / 32), I_LG = 8 * 2 * 4;
    d.ks = nullptr; d.mode = 0;
    if (part == 0) {
        if (it >= I_IN + 2 * I_LG) return false;
        int r = it;
        if (r < I_IN) { d.W = F.w_in; d.WT = (bf16_t*)(F.ws + WS_WIN); d.ks = F.ln1; d.K = D_; d.N = DIN; d.item = r; return true; } r -= I_IN;
        const bool isx = r >= I_LG; if (isx) r -= I_LG;
        const int blk = r >> 3;
        d.W = (isx ? F.gx_w : F.ga_w) + (size_t)blk * 16384; d.WT = (bf16_t*)(F.ws + (isx ? WS_GXT : WS_GAT)) + (size_t)blk * 16384; d.K = 128; d.N = 128; d.item = r & 7; return true;
    } else if (part == 1) {
        if (it >= I_OUT + 2 * I_G) return false;
        int r = it;
        if (r < I_OUT) { d.W = F.w_out; d.WT = (bf16_t*)(F.ws + WS_WOUT); d.K = D_; d.N = D_; d.item = r; return true; } r -= I_OUT;
        const bool isu = r >= I_G; if (isu) r -= I_G;
        d.W = isu ? F.w_u : F.w_g; d.WT = (bf16_t*)(F.ws + WS_WGU); d.ks = F.ln2; d.K = D_; d.N = DFF; d.mode = isu ? 2 : 1; d.item = r; return true;
    }
    if (it >= I_D) return false;
    d.W = F.w_d; d.WT = (bf16_t*)(F.ws + WS_WD); d.K = DFF; d.N = D_; d.item = it; return true;
}
__device__ __forceinline__ void x_load(const Ctx& F, int m, f32x4 (&v)[8]) {
    const f32x4* xr = (const f32x4*)(F.x + (size_t)m * D_) + F.lane;
#pragma unroll
    for (int j = 0; j < 8; ++j) v[j] = xr[64 * j];
}
__device__ __forceinline__ void x_store(const Ctx& F, int m, const f32x4 (&v)[8]) {
    float s = 0.f;
#pragma unroll
    for (int j = 0; j < 8; ++j) s += (v[j][0] * v[j][0] + v[j][1] * v[j][1]) + (v[j][2] * v[j][2] + v[j][3] * v[j][3]);
    s = wave_sum(s);
    if (F.lane == 0) ((float*)(F.ws + WS_RSTD1))[m] = 1.0f / sqrtf(s * (1.0f / D_) + EPS);
    u32x2* o8 = (u32x2*)((bf16_t*)F.out + (size_t)m * D_) + F.lane;
#pragma unroll
    for (int j = 0; j < 8; ++j) { u32x2 w; w.x = pk2(v[j][0], v[j][1]); w.y = pk2(v[j][2], v[j][3]); o8[64 * j] = w; }
}
__device__ __forceinline__ void p0_prologue(Ctx& F, int part, int gw, int NGW) {
    LAS float* scr = (LAS float*)(F.lds + F.wave * 8704);
    {
        TDesc dA, dB; float vA[32], vB[32]; f32x4 a0, a1, b0, b1;
        int it = gw;
        bool hA = p0_desc(F, part, it, dA);
        if (hA) t_load(dA, F.lane, vA, a0, a1);
        while (hA) {
            const bool hB = p0_desc(F, part, it + NGW, dB);
            if (hB) t_load(dB, F.lane, vB, b0, b1);
            t_store(dA, F.lane, vA, a0, a1, scr);
            if (!hB) break;
            hA = p0_desc(F, part, it + 2 * NGW, dA);
            if (hA) t_load(dA, F.lane, vA, a0, a1);
            t_store(dB, F.lane, vB, b0, b1, scr);
            it += 2 * NGW;
        }
    }
    if (part != 0) return;
    {
        f32x4 vA[8], vB[8];
        int m = gw;
        if (m < S_) x_load(F, m, vA);
        while (m < S_) {
            const int mb = m + NGW;
            if (mb < S_) x_load(F, mb, vB);
            x_store(F, m, vA);
            if (mb >= S_) break;
            m = mb + NGW;
            if (m < S_) x_load(F, m, vA);
            x_store(F, mb, vB);
        }
    }
}

template <bool FINAL>
__device__ __forceinline__ void p2_lru(Ctx& F, int cpart, int cbase, int cstep, int cslots) {
    const bf16_t* proj = (const bf16_t*)(F.ws + WS_PROJ);
    const bf16_t* GaT = (const bf16_t*)(F.ws + WS_GAT); const bf16_t* GxT = (const bf16_t*)(F.ws + WS_GXT);
    float* Atot = (float*)(F.ws + WS_ATOT); float* Hend = (float*)(F.ws + WS_HEND);
    const float* carry = (const float*)(F.ws + WS_CARRY); bf16_t* Y = (bf16_t*)(F.ws + WS_Y);
    LAS float* XC = (LAS float*)F.lds;
    LAS float* HB = (LAS float*)(F.lds + 33792);
    const int w = F.wave, lane = F.lane, r16 = lane & 15, g4 = lane >> 4;
    int curn = -1; bf16x8 Ba[4], Bx[4]; float bar = 0.f, bxr = 0.f, kch = 0.f;
    float cw0[4] = {0.f, 0.f, 0.f, 0.f}, cw1[4] = {0.f, 0.f, 0.f, 0.f}; f32x2 cb = (f32x2){0.f, 0.f};
    unsigned xn[11];
    { const int it0 = F.bid; const int n0 = it0 & 7, tb = (it0 >> 3) * LCH + w * 8 - 3;
#pragma unroll
      for (int i = 0; i < 11; ++i) { const int t = tb + i; xn[i] = 0u; if (it0 < NLCH * 8 && t >= 0) xn[i] = *(const unsigned*)(proj + (size_t)t * DIN + n0 * 128 + 2 * lane); } }
    LAS float* cscr = (LAS float*)(F.lds + 69632 + w * 8704);
    int slot = 0;
    for (int it = F.bid; it < NLCH * 8; it += F.G, ++slot) {
        const int n = it & 7, chunk = it >> 3, t0 = chunk * LCH;
        const int chl = 16 * w + r16, ch = n * 128 + chl;
        TDesc cd; float cv[32]; f32x4 cs0, cs1;
        const bool hc = (slot < cslots) && p0_desc(F, cpart, cbase + slot * cstep, cd);
        if (n != curn) { curn = n;
#pragma unroll
            for (int kk = 0; kk < 4; ++kk) { Ba[kk] = *(const bf16x8*)(GaT + ((size_t)n * 128 + chl) * 128 + 32 * kk + 8 * g4); Bx[kk] = *(const bf16x8*)(GxT + ((size_t)n * 128 + chl) * 128 + 32 * kk + 8 * g4); }
            bar = F.ga_b[ch]; bxr = F.gx_b[ch];
            const float lm = F.lam[ch]; const float logsig = -log1pf(expf(-lm));
            kch = 8.0f * logsig;
#pragma unroll
            for (int k = 0; k < 4; ++k) { const f32x2 c2 = *(const f32x2*)(F.conv_w + k * DLRU + n * 128 + 2 * lane); cw0[k] = c2[0]; cw1[k] = c2[1]; }
            cb = *(const f32x2*)(F.conv_b + n * 128 + 2 * lane);
        }
        const int etok = F.tid >> 3, ec16 = (F.tid & 7) * 16;
        u32x4 gq0 = (u32x4){0u, 0u, 0u, 0u}, gq1 = gq0; float Hc = 0.f;
        if constexpr (FINAL) { const bf16_t* gp = proj + (size_t)(t0 + etok) * DIN + DLRU + n * 128 + ec16; gq0 = *(const u32x4*)gp; gq1 = *(const u32x4*)(gp + 8); Hc = carry[chunk * DLRU + ch]; }
        { const int cp = lane, tg = w;
          float xw0[11], xw1[11];
#pragma unroll
          for (int i = 0; i < 11; ++i) { xw0[i] = bf_lo(xn[i]); xw1[i] = bf_hi(xn[i]); }
#pragma unroll
          for (int j = 0; j < 8; ++j) { float y0 = cb[0], y1 = cb[1];
#pragma unroll
              for (int k = 0; k < 4; ++k) { y0 += cw0[k] * xw0[j + k]; y1 += cw1[k] * xw1[j + k]; }
              *(LAS f32x2*)(XC + (tg * 8 + j) * 132 + 2 * cp) = (f32x2){y0, y1}; }
        }
        __syncthreads();
        { const int itn = it + F.G; const int nn = itn & 7, tb = (itn >> 3) * LCH + w * 8 - 3;
          if (itn < NLCH * 8) {
#pragma unroll
            for (int i = 0; i < 11; ++i) xn[i] = *(const unsigned*)(proj + (size_t)(tb + i) * DIN + nn * 128 + 2 * lane); } }
        if (hc) t_load(cd, lane, cv, cs0, cs1);
        float Pc = 1.f;
#pragma unroll
        for (int m = 0; m < 4; ++m) {
            f32x4 ar = (f32x4){0.f, 0.f, 0.f, 0.f}, ax = (f32x4){0.f, 0.f, 0.f, 0.f};
#pragma unroll
            for (int kk = 0; kk < 4; ++kk) { const LAS float* xr = XC + (16 * m + r16) * 132 + 32 * kk + 8 * g4;
                const f32x4 x0 = *(const LAS f32x4*)xr, x1 = *(const LAS f32x4*)(xr + 4);
                u32x4 pw; pw.x = pk2(x0[0], x0[1]); pw.y = pk2(x0[2], x0[3]); pw.z = pk2(x1[0], x1[1]); pw.w = pk2(x1[2], x1[3]);
                const bf16x8 af = __builtin_bit_cast(bf16x8, pw);
                ar = __builtin_amdgcn_mfma_f32_16x16x32_bf16(af, Ba[kk], ar, 0, 0, 0);
                ax = __builtin_amdgcn_mfma_f32_16x16x32_bf16(af, Bx[kk], ax, 0, 0, 0); }
            float P[4], H[4];
#pragma unroll
            for (int jj = 0; jj < 4; ++jj) { const int tok = 16 * m + 4 * g4 + jj;
                const float xc = XC[tok * 132 + chl];
                const float r = sigm(ar[jj] + bar), ig = sigm(ax[jj] + bxr);
                const float la = kch * r;
                const float a = __builtin_amdgcn_exp2f(la * 1.4426950408889634f);
                const float z = 2.0f * la;
                const float om = z > -4e-3f ? -z * (1.f + z * (0.5f + z * (1.f / 6.f))) : __builtin_fmaf(-a, a, 1.0f);
                const float b = __builtin_amdgcn_sqrtf(fmaxf(om, 0.f)) * (ig * xc);
                if (jj == 0) { P[0] = a; H[0] = b; } else { P[jj] = a * P[jj - 1]; H[jj] = a * H[jj - 1] + b; } }
            float Pt = P[3], Ht = H[3];
            float Pq = __shfl_up(Pt, 16), Hq = __shfl_up(Ht, 16); if (g4 >= 1) { Ht = Pt * Hq + Ht; Pt = Pt * Pq; }
            Pq = __shfl_up(Pt, 32); Hq = __shfl_up(Ht, 32); if (g4 >= 2) { Ht = Pt * Hq + Ht; Pt = Pt * Pq; }
            float Pe = __shfl_up(Pt, 16), He = __shfl_up(Ht, 16); if (g4 == 0) { Pe = 1.f; He = 0.f; }
            if constexpr (FINAL) {
                const float Hpre = Pe * Hc + He;
#pragma unroll
                for (int jj = 0; jj < 4; ++jj) HB[(16 * m + 4 * g4 + jj) * 132 + chl] = P[jj] * Hpre + H[jj];
            }
            const float Ptile = __shfl(Pt, r16 + 48), Htile = __shfl(Ht, r16 + 48);
            Hc = Ptile * Hc + Htile; Pc = Ptile * Pc;
        }
        if constexpr (!FINAL) { if (g4 == 0) { Atot[chunk * DLRU + ch] = Pc; Hend[chunk * DLRU + ch] = Hc; } }
        __syncthreads();
        if constexpr (FINAL) {
            const LAS float* hr = HB + etok * 132 + ec16;
            float hv[16], g[16];
#pragma unroll
            for (int q = 0; q < 4; ++q) { const f32x4 v = *(const LAS f32x4*)(hr + 4 * q); hv[4 * q] = v[0]; hv[4 * q + 1] = v[1]; hv[4 * q + 2] = v[2]; hv[4 * q + 3] = v[3]; }
#pragma unroll
            for (int q = 0; q < 4; ++q) { g[2 * q] = bf_lo(gq0[q]); g[2 * q + 1] = bf_hi(gq0[q]); g[8 + 2 * q] = bf_lo(gq1[q]); g[8 + 2 * q + 1] = bf_hi(gq1[q]); }
            float o[16];
#pragma unroll
            for (int j = 0; j < 16; ++j) { const float u = 0.7978845608028654f * (g[j] + 0.044715f * g[j] * g[j] * g[j]); o[j] = hv[j] * g[j] * sigm(2.0f * u); }
            u32x4 w0, w1;
#pragma unroll
            for (int q = 0; q < 4; ++q) { w0[q] = pk2(o[2 * q], o[2 * q + 1]); w1[q] = pk2(o[8 + 2 * q], o[8 + 2 * q + 1]); }
            bf16_t* yo = Y + (size_t)(t0 + etok) * D_ + n * 128 + ec16;
            *(u32x4*)yo = w0; *(u32x4*)(yo + 8) = w1;
        }
        if (hc) t_store(cd, lane, cv, cs0, cs1, cscr);
    }
}

__device__ __forceinline__ void rope8(const u32x4 a, const u32x4 b, const f32x4 c0, const f32x4 c1, const f32x4 s0, const f32x4 s1, float scale, u32x4& oa, u32x4& ob) {
    float x1[8], x2[8], c[8], s[8], o1[8], o2[8];
#pragma unroll
    for (int i = 0; i < 4; ++i) { x1[2 * i] = bf_lo(a[i]); x1[2 * i + 1] = bf_hi(a[i]); x2[2 * i] = bf_lo(b[i]); x2[2 * i + 1] = bf_hi(b[i]); c[i] = c0[i]; c[4 + i] = c1[i]; s[i] = s0[i]; s[4 + i] = s1[i]; }
#pragma unroll
    for (int i = 0; i < 8; ++i) { o1[i] = (x1[i] * c[i] - x2[i] * s[i]) * scale; o2[i] = (x1[i] * s[i] + x2[i] * c[i]) * scale; }
#pragma unroll
    for (int i = 0; i < 4; ++i) { oa[i] = pk2(o1[2 * i], o1[2 * i + 1]); ob[i] = pk2(o2[2 * i], o2[2 * i + 1]); }
}
struct RopeC { float hi[16], lo[16]; };
__device__ __forceinline__ void rope_init(RopeC& R, int g4) {
#pragma unroll
    for (int j = 0; j < 16; ++j) { const int f = 32 * (j >> 3) + 8 * g4 + (j & 7);
        const double c = exp2(-(double)f * (13.287712379549449 / 64.0)) * 0.15915494309189535;
        const float hh = (float)c; R.hi[j] = hh; R.lo[j] = (float)(c - (double)hh); }
}
template <int K2>
__device__ __forceinline__ void rope_cs(const RopeC& R, float tpos, f32x4& c0, f32x4& c1, f32x4& s0, f32x4& s1) {
#pragma unroll
    for (int i = 0; i < 8; ++i) { const float hh = R.hi[K2 * 8 + i], p = tpos * hh, e = __builtin_fmaf(tpos, hh, -p);
        const float r = __builtin_amdgcn_fractf(p) + (e + tpos * R.lo[K2 * 8 + i]);
        const float cv = __builtin_amdgcn_cosf(r), sv = __builtin_amdgcn_sinf(r);
        if (i < 4) { c0[i] = cv; s0[i] = sv; } else { c1[i - 4] = cv; s1[i - 4] = sv; } }
}
__device__ __forceinline__ float log2gamma(int h) { return log1pf(-exp2f(-5.0f - (float)h)) * 1.4426950408889634f; }

__device__ __forceinline__ void p2_ret(Ctx& F) {
    const bf16_t* proj = (const bf16_t*)(F.ws + WS_PROJ);
    bf16_t* kvT = (bf16_t*)(F.ws + WS_KV);
    LAS bf16_t* KT = (LAS bf16_t*)F.lds;
    LAS bf16_t* VT = (LAS bf16_t*)(F.lds + 34816);
    const int w = F.wave, lane = F.lane, r16 = lane & 15, g4 = lane >> 4;
    const int tl = 16 * w + r16;
    RopeC RC; rope_init(RC, g4);
    u32x4 kc[4], vc[4];
#pragma unroll
    for (int kk = 0; kk < 4; ++kk) { kc[kk] = (u32x4){0u, 0u, 0u, 0u}; vc[kk] = kc[kk]; }
    if (F.bid < NRCH * 8) { const bf16_t* prow = proj + (size_t)((F.bid >> 3) * RCH + tl) * DIN + (F.bid & 7) * 128 + 8 * g4;
#pragma unroll
        for (int kk = 0; kk < 4; ++kk) { kc[kk] = *(const u32x4*)(prow + 3072 + 32 * kk); vc[kk] = *(const u32x4*)(prow + 4096 + 32 * kk); } }
    for (int it = F.bid; it < NRCH * 8; it += F.G) {
        const int h = it & 7, n = it >> 3, t0 = n * RCH;
        const float lg2 = log2gamma(h);
        u32x4 kr[4];
        { f32x4 c0, c1, s0, s1; const float tpos = (float)(t0 + tl);
          rope_cs<0>(RC, tpos, c0, c1, s0, s1); rope8(kc[0], kc[2], c0, c1, s0, s1, 0.08838834764831845f, kr[0], kr[2]);
          rope_cs<1>(RC, tpos, c0, c1, s0, s1); rope8(kc[1], kc[3], c0, c1, s0, s1, 0.08838834764831845f, kr[1], kr[3]); }
        const float zeta = __builtin_amdgcn_exp2f((float)(127 - tl) * lg2);
#pragma unroll
        for (int kk = 0; kk < 4; ++kk)
#pragma unroll
            for (int i = 0; i < 4; ++i) { const int d = 32 * kk + 8 * g4 + 2 * i;
                KT[d * 136 + tl] = (bf16_t)(kr[kk][i] & 0xffffu); KT[(d + 1) * 136 + tl] = (bf16_t)(kr[kk][i] >> 16);
                const unsigned vz = pk2(bf_lo(vc[kk][i]) * zeta, bf_hi(vc[kk][i]) * zeta);
                VT[d * 136 + tl] = (bf16_t)(vz & 0xffffu); VT[(d + 1) * 136 + tl] = (bf16_t)(vz >> 16); }
        __syncthreads();
        { const int itn = it + F.G;
          if (itn < NRCH * 8) { const bf16_t* prow = proj + (size_t)((itn >> 3) * RCH + tl) * DIN + (itn & 7) * 128 + 8 * g4;
#pragma unroll
            for (int kk = 0; kk < 4; ++kk) { kc[kk] = *(const u32x4*)(prow + 3072 + 32 * kk); vc[kk] = *(const u32x4*)(prow + 4096 + 32 * kk); } } }
        bf16x8 af[4];
#pragma unroll
        for (int kk = 0; kk < 4; ++kk) af[kk] = *(const LAS bf16x8*)(KT + (16 * w + r16) * 136 + 32 * kk + 8 * g4);
        bf16_t* dst = kvT + ((size_t)(n * 8 + h) * 128 + r16) * 128 + 16 * w + 4 * g4;
#pragma unroll
        for (int ne = 0; ne < 8; ++ne) { f32x4 acc = (f32x4){0.f, 0.f, 0.f, 0.f};
#pragma unroll
            for (int kk = 0; kk < 4; ++kk) { const bf16x8 bfr = *(const LAS bf16x8*)(VT + (16 * ne + r16) * 136 + 32 * kk + 8 * g4); acc = __builtin_amdgcn_mfma_f32_16x16x32_bf16(af[kk], bfr, acc, 0, 0, 0); }
            u32x2 o; o.x = pk2_sw(acc[0], acc[1]); o.y = pk2_sw(acc[2], acc[3]);
            *(u32x2*)(dst + (size_t)(16 * ne) * 128) = o; }
        __syncthreads();
    }
}

__device__ __forceinline__ void p3_carries(Ctx& F) {
    const int gw = F.wave * F.G + F.bid, NGW = F.G * NWAVES, lane = F.lane;
    const bf16_t* kvT = (const bf16_t*)(F.ws + WS_KV); bf16_t* Rp = (bf16_t*)(F.ws + WS_RP);
    const float* Atot = (const float*)(F.ws + WS_ATOT); const float* Hend = (const float*)(F.ws + WS_HEND); float* carry = (float*)(F.ws + WS_CARRY);
    constexpr int NRT = 8 * 128 * 128 / 128;
    constexpr int NLT = DLRU / 8;
    for (int task = gw; task < NRT + NLT; task += NGW) {
        if (task < NRT) {
            const int e2 = task * 128 + 2 * lane, h = e2 >> 14;
            const float gC = exp2f(128.0f * log2gamma(h));
            unsigned kv[NRCH];
#pragma unroll
            for (int j = 0; j < NRCH; ++j) kv[j] = *(const unsigned*)(kvT + (size_t)j * 131072 + e2);
            float r0 = 0.f, r1 = 0.f;
#pragma unroll
            for (int j = 0; j < NRCH; ++j) { *(unsigned*)(Rp + (size_t)j * 131072 + e2) = pk2(r0, r1); r0 = r0 * gC + bf_lo(kv[j]); r1 = r1 * gC + bf_hi(kv[j]); }
        } else {
            const int ch = (task - NRT) * 8 + (lane & 7), seg = lane >> 3, c0 = seg * 16;
            float av[16], hv[16];
#pragma unroll
            for (int j = 0; j < 16; ++j) { av[j] = Atot[(c0 + j) * DLRU + ch]; hv[j] = Hend[(c0 + j) * DLRU + ch]; }
            float A = 1.f, H = 0.f;
#pragma unroll
            for (int j = 0; j < 16; ++j) { H = av[j] * H + hv[j]; A = av[j] * A; }
#pragma unroll
            for (int o = 8; o < 64; o <<= 1) { const float Ap = __shfl_up(A, o), Hp = __shfl_up(H, o); if (lane >= o) { H = A * Hp + H; A = A * Ap; } }
            float Hc = __shfl_up(H, 8); if (seg == 0) Hc = 0.f;
#pragma unroll
            for (int j = 0; j < 16; ++j) { carry[(c0 + j) * DLRU + ch] = Hc; Hc = av[j] * Hc + hv[j]; }
        }
    }
}

__device__ __forceinline__ void p4_ret_preload(Ctx& F, u32x4 (&qc)[4], u32x4 (&kc)[4], u32x4 (&vc)[4], u32x4 (&gq)[4]) {
    const bf16_t* proj = (const bf16_t*)(F.ws + WS_PROJ);
    const int w = F.wave, lane = F.lane, r16 = lane & 15, g4 = lane >> 4, orow = lane >> 2, ocol = (lane & 3) * 32, tl = 16 * w + r16;
#pragma unroll
    for (int kk = 0; kk < 4; ++kk) { qc[kk] = (u32x4){0u, 0u, 0u, 0u}; kc[kk] = qc[kk]; vc[kk] = qc[kk]; gq[kk] = qc[kk]; }
    if (F.bid < NRCH * 8) { const int h0 = F.bid & 7, tb = (F.bid >> 3) * RCH;
        const bf16_t* prow = proj + (size_t)(tb + tl) * DIN + h0 * 128 + 8 * g4;
#pragma unroll
        for (int kk = 0; kk < 4; ++kk) { qc[kk] = *(const u32x4*)(prow + 2048 + 32 * kk); kc[kk] = *(const u32x4*)(prow + 3072 + 32 * kk); vc[kk] = *(const u32x4*)(prow + 4096 + 32 * kk); }
        const bf16_t* gp = proj + (size_t)(tb + 16 * w + orow) * DIN + 5120 + h0 * 128 + ocol;
#pragma unroll
        for (int i = 0; i < 4; ++i) gq[i] = *(const u32x4*)(gp + 8 * i); }
}
__device__ __forceinline__ void p4_ret(Ctx& F, u32x4 (&qc)[4], u32x4 (&kc)[4], u32x4 (&vc)[4], u32x4 (&gq)[4]) {
    const bf16_t* proj = (const bf16_t*)(F.ws + WS_PROJ); bf16_t* Y = (bf16_t*)(F.ws + WS_Y);
    const bf16_t* Rp = (const bf16_t*)(F.ws + WS_RP);
    LAS bf16_t* KS = (LAS bf16_t*)F.lds;
    LAS bf16_t* VT = (LAS bf16_t*)(F.lds + 34816);
    LAS unsigned char* RL = F.lds + 104448;
    const int w = F.wave, lane = F.lane, r16 = lane & 15, g4 = lane >> 4;
    LAS bf16_t* PS = (LAS bf16_t*)(F.lds + 69632) + w * (16 * 136);
    const int orow = lane >> 2, ocol = (lane & 3) * 32;
    const int tl = 16 * w + r16;
    RopeC RC; rope_init(RC, g4);
    for (int it = F.bid; it < NRCH * 8; it += F.G) {
        const int h = it & 7, n = it >> 3, t0 = n * RCH;
        const float lg2 = log2gamma(h);
        { const char* rg = (const char*)(Rp + (size_t)(n * 8 + h) * 16384);
#pragma unroll
          for (int i = 0; i < 4; ++i) { const int e = i * 32 + w * 4 + (lane >> 4), pos = lane & 15;
              __builtin_amdgcn_global_load_lds((const unsigned*)(rg + e * 256 + ((pos ^ (e & 15)) * 16)), (LAS unsigned*)(RL + i * 8192 + w * 1024), 16, 0, 0); } }
        u32x4 qf[4], go[4];
        {
            u32x4 kr[4];
            { f32x4 c0, c1, s0, s1; const float tpos = (float)(t0 + tl);
              rope_cs<0>(RC, tpos, c0, c1, s0, s1); rope8(qc[0], qc[2], c0, c1, s0, s1, 1.0f, qf[0], qf[2]); rope8(kc[0], kc[2], c0, c1, s0, s1, 0.08838834764831845f, kr[0], kr[2]);
              rope_cs<1>(RC, tpos, c0, c1, s0, s1); rope8(qc[1], qc[3], c0, c1, s0, s1, 1.0f, qf[1], qf[3]); rope8(kc[1], kc[3], c0, c1, s0, s1, 0.08838834764831845f, kr[1], kr[3]); }
#pragma unroll
            for (int kk = 0; kk < 4; ++kk) { *(LAS u32x4*)(KS + tl * 136 + 32 * kk + 8 * g4) = kr[kk];
#pragma unroll
                for (int i = 0; i < 4; ++i) { const int e = 32 * kk + 8 * g4 + 2 * i; VT[e * 136 + tl] = (bf16_t)(vc[kk][i] & 0xffffu); VT[(e + 1) * 136 + tl] = (bf16_t)(vc[kk][i] >> 16); } }
#pragma unroll
            for (int i = 0; i < 4; ++i) go[i] = gq[i];
        }
        asm volatile("s_waitcnt vmcnt(0)" ::: "memory");
        __syncthreads();
        { const int itn = it + F.G;
          if (itn < NRCH * 8) { const int hn = itn & 7, tb = (itn >> 3) * RCH;
            const bf16_t* prow = proj + (size_t)(tb + tl) * DIN + hn * 128 + 8 * g4;
#pragma unroll
            for (int kk = 0; kk < 4; ++kk) { qc[kk] = *(const u32x4*)(prow + 2048 + 32 * kk); kc[kk] = *(const u32x4*)(prow + 3072 + 32 * kk); vc[kk] = *(const u32x4*)(prow + 4096 + 32 * kk); }
            const bf16_t* gp = proj + (size_t)(tb + 16 * w + orow) * DIN + 5120 + hn * 128 + ocol;
#pragma unroll
            for (int i = 0; i < 4; ++i) gq[i] = *(const u32x4*)(gp + 8 * i); } }
#pragma unroll
        for (int nn = 0; nn < 8; ++nn) {
            if (nn <= w) {
                f32x4 acc = (f32x4){0.f, 0.f, 0.f, 0.f};
#pragma unroll
                for (int kk = 0; kk < 4; ++kk) { const bf16x8 kf = *(const LAS bf16x8*)(KS + (16 * nn + r16) * 136 + 32 * kk + 8 * g4); acc = __builtin_amdgcn_mfma_f32_16x16x32_bf16(__builtin_bit_cast(bf16x8, qf[kk]), kf, acc, 0, 0, 0); }
#pragma unroll
                for (int jj = 0; jj < 4; ++jj) { const int diff = (16 * w + 4 * g4 + jj) - (16 * nn + r16);
                    const float p = diff >= 0 ? acc[jj] * __builtin_amdgcn_exp2f((float)diff * lg2) : 0.f;
                    PS[(4 * g4 + jj) * 136 + 16 * nn + r16] = (bf16_t)(pk2(p, 0.f) & 0xffffu); }
            } else if (nn <= (w | 1)) {
#pragma unroll
                for (int jj = 0; jj < 4; ++jj) PS[(4 * g4 + jj) * 136 + 16 * nn + r16] = (bf16_t)0;
            }
        }
        asm volatile("s_waitcnt lgkmcnt(0)" ::: "memory");
        f32x4 O[8];
#pragma unroll
        for (int ne = 0; ne < 8; ++ne) O[ne] = (f32x4){0.f, 0.f, 0.f, 0.f};
#pragma unroll
        for (int k2 = 0; k2 < 4; ++k2) {
            if (k2 <= (w >> 1)) {
                const bf16x8 pf = *(const LAS bf16x8*)(PS + r16 * 136 + 32 * k2 + 8 * g4);
#pragma unroll
                for (int ne = 0; ne < 8; ++ne) { const bf16x8 vf = *(const LAS bf16x8*)(VT + (16 * ne + r16) * 136 + 32 * k2 + 8 * g4); O[ne] = __builtin_amdgcn_mfma_f32_16x16x32_bf16(pf, vf, O[ne], 0, 0, 0); }
            }
        }
        float xi[4];
#pragma unroll
        for (int jj = 0; jj < 4; ++jj) xi[jj] = __builtin_amdgcn_exp2f((float)(16 * w + 4 * g4 + jj + 1) * lg2);
#pragma unroll
        for (int ne = 0; ne < 8; ++ne) { f32x4 cx = (f32x4){0.f, 0.f, 0.f, 0.f};
#pragma unroll
            for (int kk = 0; kk < 4; ++kk) { const bf16x8 rf = *(const LAS bf16x8*)(RL + (16 * ne + r16) * 256 + (((4 * kk + g4) ^ r16) * 16)); cx = __builtin_amdgcn_mfma_f32_16x16x32_bf16(__builtin_bit_cast(bf16x8, qf[kk]), rf, cx, 0, 0, 0); }
#pragma unroll
            for (int jj = 0; jj < 4; ++jj) O[ne][jj] += xi[jj] * cx[jj]; }
        float gnw[8];
#pragma unroll
        for (int ne = 0; ne < 8; ++ne) gnw[ne] = F.gn_w[h * 128 + 16 * ne + r16];
#pragma unroll
        for (int jj = 0; jj < 4; ++jj) {
            float s = 0.f;
#pragma unroll
            for (int ne = 0; ne < 8; ++ne) s += O[ne][jj];
            s += __shfl_xor(s, 1); s += __shfl_xor(s, 2); s += __shfl_xor(s, 4); s += __shfl_xor(s, 8);
            const float mu = s * (1.0f / 128.0f); float q = 0.f;
#pragma unroll
            for (int ne = 0; ne < 8; ++ne) { const float d = O[ne][jj] - mu; q += d * d; }
            q += __shfl_xor(q, 1); q += __shfl_xor(q, 2); q += __shfl_xor(q, 4); q += __shfl_xor(q, 8);
            const float rstd = __builtin_amdgcn_rsqf(q * (1.0f / 128.0f) + EPS);
#pragma unroll
            for (int ne = 0; ne < 8; ++ne) { const float on = (O[ne][jj] - mu) * rstd * gnw[ne];
                PS[(4 * g4 + jj) * 136 + 16 * ne + r16] = (bf16_t)(pk2(on, 0.f) & 0xffffu); }
        }
        asm volatile("s_waitcnt lgkmcnt(0)" ::: "memory");
        { bf16_t* yo = Y + (size_t)(t0 + 16 * w + orow) * D_ + DLRU + h * 128 + ocol;
#pragma unroll
          for (int i = 0; i < 4; ++i) { const u32x4 ov = *(const LAS u32x4*)(PS + orow * 136 + ocol + 8 * i); u32x4 wv;
#pragma unroll
              for (int j = 0; j < 4; ++j) { const float g0 = bf_lo(go[i][j]), g1 = bf_hi(go[i][j]); wv[j] = pk2(bf_lo(ov[j]) * (g0 * sigm(g0)), bf_hi(ov[j]) * (g1 * sigm(g1))); }
              *(u32x4*)(yo + 8 * i) = wv; } }
        __syncthreads();
    }
}

__device__ __forceinline__ void p8_final(Ctx& F) {
    const int gw = F.bid * NWAVES + F.wave, NGW = F.G * NWAVES;
    const float* ss3 = (const float*)(F.ws + WS_SS3);
    for (int m = gw; m < S_; m += NGW) {
        const f32x4 p0 = *(const f32x4*)(ss3 + (size_t)m * 8), p1 = *(const f32x4*)(ss3 + (size_t)m * 8 + 4);
        const float tot = ((p0[0] + p0[1]) + (p0[2] + p0[3])) + ((p1[0] + p1[1]) + (p1[2] + p1[3]));
        const float rstd = 1.0f / sqrtf(tot * (1.0f / D_) + EPS);
        f32x4* xr = (f32x4*)(F.out + (size_t)m * D_) + F.lane; const f32x4* wr = (const f32x4*)F.fnw + F.lane;
#pragma unroll
        for (int j = 0; j < 8; ++j) { const f32x4 v = xr[64 * j], wv = wr[64 * j]; xr[64 * j] = v * rstd * wv; }
    }
}

__global__ void __launch_bounds__(NTHR, 2) hymba_fwd(Args args) {
    extern __shared__ __attribute__((aligned(16))) unsigned char lds_raw[];
    Ctx F;
    F.lds = (LAS unsigned char*)lds_raw;
    F.tid = threadIdx.x; F.lane = F.tid & 63; F.wave = __builtin_amdgcn_readfirstlane(F.tid >> 6); F.G = gridDim.x; F.bid = blockIdx.x;
    F.x = args.in[0]; F.ln1 = args.in[1]; F.w_in = args.in[2]; F.conv_w = args.in[3]; F.conv_b = args.in[4]; F.ga_w = args.in[5]; F.ga_b = args.in[6]; F.gx_w = args.in[7];
    F.gx_b = args.in[8]; F.lam = args.in[9]; F.gn_w = args.in[10]; F.w_out = args.in[11]; F.ln2 = args.in[12]; F.w_g = args.in[13]; F.w_u = args.in[14]; F.w_d = args.in[15]; F.fnw = args.in[16];
    F.out = args.out; F.ws = args.ws;
    const int lo = args.ph_lo, hi = args.ph_hi;
#define IN(k) (lo <= (k) && (k) < hi)
#define SEAM(k) do { if (IN(k) && IN((k) + 1)) { xcd_barrier(bar); } } while (0)
    unsigned char* ws = args.ws;
    XcdBarrier bar; bar.bar = (unsigned*)(ws + WS_BAR); bar.x = 0; bar.st = (volatile LAS unsigned*)(F.lds + LDS_CTL);
    if (hi - lo > 1) {
        if (F.tid < 4) ((LAS unsigned*)(F.lds + LDS_CTL))[F.tid] = 0u;
        __syncthreads();
        bar = xcd_barrier_post((unsigned*)(ws + WS_BAR), (volatile LAS unsigned*)(F.lds + LDS_CTL));
    }
    if (lo == 12345) cg::this_grid().sync();

    if (IN(0)) { p0_prologue(F, 0, F.bid * NWAVES + F.wave, F.G * NWAVES); }
    SEAM(0);
    if (IN(1)) {
        pg8::Gemm g{(const bf16_t*)F.out, (const bf16_t*)(ws + WS_WIN), S_, DIN, D_}; pg8::StaticOrder S; S.init(S_, DIN, F.G, F.bid);
        pg8::EpiProj E{(bf16_t*)(ws + WS_PROJ), DIN, (const float*)(ws + WS_RSTD1)};
        pg8::gemm_phase<pg8::EpiProj, pg8::StaticOrder, true, true>(F.lds, g, S, E);
        if (REP_MASK & 2) pg8::gemm_phase<pg8::EpiProj, pg8::StaticOrder, true, true>(F.lds, g, S, E);
    }
    SEAM(1);
    if (IN(2)) { p2_lru<false>(F, 1, F.bid * NWAVES + F.wave, F.G * NWAVES, 4);   p2_ret(F); }
    SEAM(2);
    u32x4 pq[4], pk[4], pv[4], pg[4];
    if (IN(3)) { p4_ret_preload(F, pq, pk, pv, pg); p3_carries(F); }
    SEAM(3);
    if (IN(4)) { if (!IN(3)) p4_ret_preload(F, pq, pk, pv, pg); p4_ret(F, pq, pk, pv, pg);   p2_lru<true>(F, 1, (F.bid + 4 * F.G) * NWAVES + F.wave, F.G * NWAVES, 1 << 20);
        p0_prologue(F, 1, (F.bid + (4 + (NLCH * 8 + F.G - 1) / F.G) * F.G) * NWAVES + F.wave, F.G * NWAVES); }
    SEAM(4);
    if (IN(5)) {
        pg8::Gemm g{(const bf16_t*)(ws + WS_Y), (const bf16_t*)(ws + WS_WOUT), S_, D_, D_}; pg8::StaticOrder S; S.init(S_, D_, F.G, F.bid);
        pg8::EpiResid E{(const bf16_t*)F.out, nullptr, (bf16_t*)(ws + WS_H1B), D_, (float*)(ws + WS_SS2)};
        pg8::gemm_phase<pg8::EpiResid, pg8::StaticOrder, false, true>(F.lds, g, S, E);
        if (REP_MASK & 32) pg8::gemm_phase<pg8::EpiResid, pg8::StaticOrder, false, true>(F.lds, g, S, E);
    }
    SEAM(5);
    if (IN(6)) {
        pg8::Gemm g{(const bf16_t*)(ws + WS_H1B), (const bf16_t*)(ws + WS_WGU), S_, NGU, D_}; pg8::StaticOrder S; S.init(S_, NGU, F.G, F.bid);
        pg8::EpiSwiglu E{(bf16_t*)(ws + WS_FF), DFF, (const float*)(ws + WS_SS2)};
        pg8::gemm_phase<pg8::EpiSwiglu, pg8::StaticOrder, true, true>(F.lds, g, S, E);
        if (REP_MASK & 64) pg8::gemm_phase<pg8::EpiSwiglu, pg8::StaticOrder, true, true>(F.lds, g, S, E);
        const int nun = (S_ / 256) * (NGU / 256), full = nun / F.G, rem = nun % F.G;
        if (rem == 0) p0_prologue(F, 2, F.bid * NWAVES + F.wave, F.G * NWAVES);
        else if (F.bid >= rem) p0_prologue(F, 2, (F.bid - rem) * NWAVES + F.wave, (F.G - rem) * NWAVES);
        (void)full;
    }
    SEAM(6);
    if (IN(7)) {
        pg8::Gemm g{(const bf16_t*)(ws + WS_FF), (const bf16_t*)(ws + WS_WD), S_, D_, DFF}; pg8::StaticOrder S; S.init(S_, D_, F.G, F.bid);
        if (REP_MASK & 128) { pg8::EpiNull E{(float*)(ws + WS_SS2)}; pg8::gemm_phase<pg8::EpiNull, pg8::StaticOrder, false, true>(F.lds, g, S, E); }
        if (hi - lo > 1) {
            pg8::EpiFinal E{(const bf16_t*)(ws + WS_H1B), F.out, D_, (float*)(ws + WS_SS3), (unsigned*)(ws + WS_PCNT), F.fnw, (unsigned*)(ws + WS_PCNT + 32 * 256)};
            pg8::gemm_phase<pg8::EpiFinal, pg8::StaticOrder, false, true>(F.lds, g, S, E);
        } else {
            pg8::EpiResid E{(const bf16_t*)(ws + WS_H1B), F.out, nullptr, D_, (float*)(ws + WS_SS3)};
            pg8::gemm_phase<pg8::EpiResid, pg8::StaticOrder, false, true>(F.lds, g, S, E);
        }
    }
    if (hi - lo <= 1) { if (IN(8)) { p8_final(F); } }
#undef IN
#undef SEAM
}

extern "C" void kernel_launch(void* const* d_in, const int* in_sizes, int n_in, void* d_out, int out_size, void* d_ws, size_t ws_size, hipStream_t stream) {
    static int grid = 0;
    if (grid == 0) {
        if (n_in != 17 || out_size != S_ * D_ || ws_size < WS_END) { fprintf(stderr, "kernel_launch: unexpected shapes: n_in %d out %d ws %zu (need %zu)\n", n_in, out_size, ws_size, (size_t)WS_END); grid = -1; return; }
        int dev = 0, cus = 0, per_cu = 0;
        (void)hipGetDevice(&dev); (void)hipDeviceGetAttribute(&cus, hipDeviceAttributeMultiprocessorCount, dev);
        if (hipFuncSetAttribute((const void*)hymba_fwd, hipFuncAttributeMaxDynamicSharedMemorySize, LDS_BYTES) != hipSuccess) { fprintf(stderr, "kernel_launch: hipFuncSetAttribute failed\n"); grid = -1; return; }
        (void)hipOccupancyMaxActiveBlocksPerMultiprocessor(&per_cu, (const void*)hymba_fwd, NTHR, LDS_BYTES);
        (void)hipGetLastError();
        if (per_cu < 1) { fprintf(stderr, "kernel_launch: occupancy query says %d blocks per CU\n", per_cu); per_cu = 1; }
        grid = cus;
        if (grid != 256) fprintf(stderr, "kernel_launch: grid %d != 256: the residual GEMM phases need one unit per workgroup\n", grid);
    }
    if (grid < 0) return;
    Args a{};
    for (int i = 0; i < 17; ++i) a.in[i] = (const float*)d_in[i];
    a.out = (float*)d_out; a.ws = (unsigned char*)d_ws;
#if MK_ONE_LAUNCH
    if (hipMemsetAsync((char*)d_ws + WS_BAR, 0, CTL_ZERO_BYTES, stream) != hipSuccess) { fprintf(stderr, "kernel_launch: memset of barrier words failed\n"); return; }
    a.ph_lo = 0; a.ph_hi = 9;
    void* kargs[] = {&a};
    hipError_t e = hipLaunchCooperativeKernel((const void*)hymba_fwd, dim3(grid), dim3(NTHR), kargs, LDS_BYTES, stream);
    if (e != hipSuccess) fprintf(stderr, "kernel_launch: cooperative launch failed: %s (grid %d)\n", hipGetErrorString(e), grid);
#else
    for (int p = 0; p < 9; ++p) { a.ph_lo = p; a.ph_hi = p + 1; hipLaunchKernelGGL(hymba_fwd, dim3(grid), dim3(NTHR), LDS_BYTES, stream, a); }
#endif
}
```

```cpp
#include <hip/hip_runtime.h>
#include <hip/hip_cooperative_groups.h>
#include <cstdio>
#include <cstdint>
namespace cg = cooperative_groups;

#ifndef REP_MASK
#define REP_MASK 0
#endif
#ifndef MK_ONE_LAUNCH
#define MK_ONE_LAUNCH 1
#endif

#define LAS __attribute__((address_space(3)))
typedef unsigned short bf16_t;
typedef short bf16x8 __attribute__((ext_vector_type(8)));
typedef float f32x4 __attribute__((ext_vector_type(4)));
typedef float f32x2 __attribute__((ext_vector_type(2)));
typedef unsigned u32x4 __attribute__((ext_vector_type(4)));
typedef unsigned u32x2 __attribute__((ext_vector_type(2)));

constexpr int S_ = 8192, D_ = 2048, DIN = 6144, DLRU = 1024, DRET = 1024, DFF = 5632, NGU = 2 * DFF;
constexpr int NWAVES = 8, NTHR = 512;
constexpr float EPS = 1e-6f;
constexpr int LCH = 64;
constexpr int NLCH = S_ / LCH;
constexpr int RCH = 128, NRCH = S_ / RCH;
constexpr size_t MiB = 1u << 20;
constexpr size_t WS_RSTD1 = 0, WS_SS2 = 64 * 1024, WS_SS3 = 320 * 1024, WS_GAT = 576 * 1024, WS_GXT = 832 * 1024,
                 WS_ATOT = 1088 * 1024, WS_HEND = 1600 * 1024, WS_CARRY = 2112 * 1024;
constexpr size_t WS_ROPEC = 4 * MiB, WS_ROPES = 6 * MiB;
constexpr size_t WS_WOUT = 8 * MiB, WS_WGU = 16 * MiB, WS_WD = 60 * MiB, WS_PROJ = 82 * MiB;
constexpr size_t WS_WIN = 178 * MiB, WS_XB = 202 * MiB;
constexpr size_t WS_KV = 178 * MiB, WS_RP = 210 * MiB;
constexpr size_t WS_Y = 226 * MiB;
constexpr size_t WS_H1B = 82 * MiB, WS_FF = 114 * MiB;
constexpr size_t WS_END = 258 * MiB;
constexpr size_t WS_BAR = 2688 * 1024;
constexpr size_t WS_PCNT = WS_BAR + 16 * 1024;
constexpr size_t CTL_ZERO_BYTES = 16 * 1024 + 32 * 256 + 256;
constexpr int LDS_CTL = 163840 - 256;
constexpr int LDS_BYTES = 163840;

__device__ __forceinline__ unsigned pk2(float lo, float hi) { unsigned r; asm volatile("v_cvt_pk_bf16_f32 %0, %1, %2" : "=v"(r) : "v"(lo), "v"(hi)); return r; }
__device__ __forceinline__ unsigned pk2_sw(float lo, float hi) { unsigned a = __float_as_uint(lo), b = __float_as_uint(hi); a += 0x7fffu + ((a >> 16) & 1u); b += 0x7fffu + ((b >> 16) & 1u); return (a >> 16) | (b & 0xffff0000u); }
__device__ __forceinline__ float bf_lo(unsigned w) { return __uint_as_float(w << 16); }
__device__ __forceinline__ float bf_hi(unsigned w) { return __uint_as_float(w & 0xffff0000u); }
__device__ __forceinline__ float sigm(float z) { return __builtin_amdgcn_rcpf(1.f + __builtin_amdgcn_exp2f(-1.4426950408889634f * z)); }
__device__ __forceinline__ float wave_sum(float v) {
#pragma unroll
    for (int o = 1; o < 64; o <<= 1) v += __shfl_xor(v, o);
    return v;
}

namespace pg8 {
constexpr int BM = 256, BK = 64, HALF = 128, HTB = HALF * BK * 2, STAGE_BYTES = 8 * HTB, NXCD = 8, WGM = 8;
__host__ __device__ __forceinline__ int lds_byte(int r, int c) { const int st = (r >> 4) * 2 + (c >> 5), rr = r & 15, cc = c & 31, ob = rr * 64 + cc * 2; return st * 1024 + (ob ^ (((ob >> 9) & 1) << 5)); }
__host__ __device__ __forceinline__ void stage_rc(int b, int& R, int& C) { const int st = b / 1024, sb = b % 1024, swz = sb ^ (((sb >> 9) & 1) << 5); R = (st >> 1) * 16 + swz / 64; C = (st & 1) * 32 + (swz % 64) / 2; }
__host__ __device__ __forceinline__ int perm32(int rho) { const int n = rho >> 4, i = rho & 15; return 8 * (i >> 2) + 4 * n + (i & 3); }
struct Unit { int pm, pn; };
struct Gemm { const bf16_t* A; const bf16_t* Bt; int M, N, K; };
struct StaticOrder {
    int nM, nN, nwg, G, c;
    __host__ __device__ void init(int M, int N, int G_, int c_) { nM = M / BM; nN = N / BM; nwg = nM * nN; G = G_; c = c_; }
    __host__ __device__ bool next(int i, Unit& u) const {
        const long L = (long)i * G + c; if (L >= nwg) return false;
        int wgid = (int)L; { const int q = nwg / NXCD, r = nwg % NXCD, xcd = wgid % NXCD, off = wgid / NXCD; wgid = (xcd < r ? xcd * (q + 1) : r * (q + 1) + (xcd - r) * q) + off; }
        const int nig = WGM * nN, gid = wgid / nig, fm = gid * WGM, gsz = (nM - fm) < WGM ? (nM - fm) : WGM;
        u.pm = fm + ((wgid % nig) % gsz); u.pn = (wgid % nig) / gsz; return true;
    }
};

struct EpiProj {
    static constexpr bool PERM = true, AFTER_DRAIN = false;
    bf16_t* O; int ldc; const float* rs;
    __device__ __forceinline__ void operator()(const f32x4 (&acc)[2][2][4][2], const Unit& u, int wr, int wc, int fr, int fq) const {
        const int row0 = u.pm * BM + wr * 64 + fr, col0 = u.pn * BM + wc * 32 + 8 * fq;
#pragma unroll
        for (int ai = 0; ai < 2; ++ai)
#pragma unroll
            for (int m = 0; m < 4; ++m) { const int r = row0 + ai * HALF + m * 16; const float s = rs[r]; bf16_t* rowp = O + (size_t)r * ldc + col0;
#pragma unroll
                for (int bj = 0; bj < 2; ++bj) { const f32x4 v0 = acc[ai][bj][m][0] * s, v1 = acc[ai][bj][m][1] * s;
                    u32x4 w; w.x = pk2(v0[0], v0[1]); w.y = pk2(v0[2], v0[3]); w.z = pk2(v1[0], v1[1]); w.w = pk2(v1[2], v1[3]);
                    *(u32x4*)(rowp + bj * HALF) = w; } }
    }
};
struct EpiSwiglu {
    static constexpr bool PERM = true, AFTER_DRAIN = false;
    bf16_t* O; int ldc; const float* ss;
    __device__ __forceinline__ void operator()(const f32x4 (&acc)[2][2][4][2], const Unit& u, int wr, int wc, int fr, int fq) const {
        const int row0 = u.pm * BM + wr * 64 + fr, col0 = u.pn * HALF + wc * 32 + 8 * fq;
#pragma unroll
        for (int ai = 0; ai < 2; ++ai)
#pragma unroll
            for (int m = 0; m < 4; ++m) { const int r = row0 + ai * HALF + m * 16;
                const f32x4 p0 = *(const f32x4*)(ss + (size_t)r * 8), p1 = *(const f32x4*)(ss + (size_t)r * 8 + 4);
                const float tot = ((p0[0] + p0[1]) + (p0[2] + p0[3])) + ((p1[0] + p1[1]) + (p1[2] + p1[3]));
                const float s = __builtin_amdgcn_rsqf(tot * (1.0f / D_) + EPS);
                float o[8];
#pragma unroll
                for (int n = 0; n < 2; ++n)
#pragma unroll
                    for (int j = 0; j < 4; ++j) { const float g = acc[ai][0][m][n][j] * s, up = acc[ai][1][m][n][j] * s; o[n * 4 + j] = g * sigm(g) * up; }
                u32x4 w; w.x = pk2(o[0], o[1]); w.y = pk2(o[2], o[3]); w.z = pk2(o[4], o[5]); w.w = pk2(o[6], o[7]);
                *(u32x4*)(O + (size_t)r * ldc + col0) = w; }
    }
};
struct EpiNull { static constexpr bool PERM = true, AFTER_DRAIN = false; float* sink;
    __device__ __forceinline__ void operator()(const f32x4 (&acc)[2][2][4][2], const Unit& u, int wr, int wc, int fr, int fq) const { if (acc[0][0][0][0][0] == 123.456f) sink[0] = 1.f; } };
struct EpiResid {
    static constexpr bool PERM = true, AFTER_DRAIN = true;
    const bf16_t* base; float* out; bf16_t* ob; int ldc; float* ss;
    __device__ __forceinline__ void fused(f32x4 (&acc)[2][2][4][2], const Unit& u, int wr, int wc, int fr, int fq, LAS unsigned char* lds, int wid, int lane) const {
        LAS float* P = (LAS float*)lds;
        const int col0 = u.pn * BM + wc * 32 + 8 * fq;
#pragma unroll
        for (int ai = 0; ai < 2; ++ai)
#pragma unroll
            for (int m = 0; m < 4; ++m) { const int rl = ai * HALF + wr * 64 + m * 16 + fr; const size_t off = (size_t)(u.pm * BM + rl) * ldc + col0; float q = 0.f;
#pragma unroll
                for (int bj = 0; bj < 2; ++bj) {
                    const u32x4 bw = *(const u32x4*)(base + off + bj * HALF);
                    const f32x4 b0 = (f32x4){bf_lo(bw.x), bf_hi(bw.x), bf_lo(bw.y), bf_hi(bw.y)}, b1 = (f32x4){bf_lo(bw.z), bf_hi(bw.z), bf_lo(bw.w), bf_hi(bw.w)};
                    const f32x4 v0 = acc[ai][bj][m][0] + b0, v1 = acc[ai][bj][m][1] + b1;
                    if (out) { *(f32x4*)(out + off + bj * HALF) = v0; *(f32x4*)(out + off + bj * HALF + 4) = v1; }
                    if (ob) { u32x4 w; w.x = pk2(v0[0], v0[1]); w.y = pk2(v0[2], v0[3]); w.z = pk2(v1[0], v1[1]); w.w = pk2(v1[2], v1[3]); *(u32x4*)(ob + off + bj * HALF) = w; }
                    q += (v0[0] * v0[0] + v0[1] * v0[1]) + (v0[2] * v0[2] + v0[3] * v0[3]) + (v1[0] * v1[0] + v1[1] * v1[1]) + (v1[2] * v1[2] + v1[3] * v1[3]); }
                q += __shfl_xor(q, 16); q += __shfl_xor(q, 32);
                if (fq == 0) P[rl * 4 + wc] = q;
                if (m & 1) asm volatile("" ::: "memory"); }
        __syncthreads();
        const int t = wid * 64 + lane;
        if (t < 256) { const f32x4 p = *(const LAS f32x4*)(P + t * 4); ss[(size_t)(u.pm * BM + t) * 8 + u.pn] = (p[0] + p[1]) + (p[2] + p[3]); }
        __syncthreads();
    }
};

struct EpiFinal {
    static constexpr bool PERM = true, AFTER_DRAIN = true;
    const bf16_t* base; float* out; int ldc; float* ss; unsigned* cnt; const float* w; unsigned* tmo;
    __device__ __forceinline__ void fused(f32x4 (&acc)[2][2][4][2], const Unit& u, int wr, int wc, int fr, int fq, LAS unsigned char* lds, int wid, int lane) const {
        LAS float* P = (LAS float*)lds;
        LAS float* R = (LAS float*)(lds + 4096);
        const int col0 = u.pn * BM + wc * 32 + 8 * fq;
#pragma unroll
        for (int ai = 0; ai < 2; ++ai)
#pragma unroll
            for (int m = 0; m < 4; ++m) { const int rl = ai * HALF + wr * 64 + m * 16 + fr; const size_t off = (size_t)(u.pm * BM + rl) * ldc + col0; float q = 0.f;
#pragma unroll
                for (int bj = 0; bj < 2; ++bj) {
                    const u32x4 bw = *(const u32x4*)(base + off + bj * HALF);
                    const f32x4 b0 = (f32x4){bf_lo(bw.x), bf_hi(bw.x), bf_lo(bw.y), bf_hi(bw.y)}, b1 = (f32x4){bf_lo(bw.z), bf_hi(bw.z), bf_lo(bw.w), bf_hi(bw.w)};
                    const f32x4 v0 = acc[ai][bj][m][0] + b0, v1 = acc[ai][bj][m][1] + b1;
                    acc[ai][bj][m][0] = v0; acc[ai][bj][m][1] = v1;
                    q += (v0[0] * v0[0] + v0[1] * v0[1]) + (v0[2] * v0[2] + v0[3] * v0[3]) + (v1[0] * v1[0] + v1[1] * v1[1]) + (v1[2] * v1[2] + v1[3] * v1[3]); }
                q += __shfl_xor(q, 16); q += __shfl_xor(q, 32);
                if (fq == 0) P[rl * 4 + wc] = q;
                if (m & 1) asm volatile("" ::: "memory"); }
        __syncthreads();
        const int t = wid * 64 + lane;
        unsigned* pc = cnt + 64 * u.pm;
        if (t < 256) { const f32x4 p = *(const LAS f32x4*)(P + t * 4);
            __hip_atomic_store(ss + (size_t)(u.pm * BM + t) * 8 + u.pn, (p[0] + p[1]) + (p[2] + p[3]), __ATOMIC_RELAXED, __HIP_MEMORY_SCOPE_AGENT);
            asm volatile("s_waitcnt vmcnt(0)" ::: "memory");
            if (lane == 0) __hip_atomic_fetch_add(pc, 1u, __ATOMIC_RELAXED, __HIP_MEMORY_SCOPE_AGENT); }
        if (wid == 0) {
            unsigned sp = 0;
            while ((unsigned)__builtin_amdgcn_readfirstlane(__hip_atomic_load(pc, __ATOMIC_RELAXED, __HIP_MEMORY_SCOPE_AGENT)) < 32u) {
                __builtin_amdgcn_s_sleep(2);
                if (++sp > (1u << 22)) { if (lane == 0) __hip_atomic_store(tmo, 1u, __ATOMIC_RELAXED, __HIP_MEMORY_SCOPE_AGENT); break; } }
            __builtin_amdgcn_fence(__ATOMIC_ACQUIRE, "agent");
            asm volatile("s_waitcnt vmcnt(0)" ::: "memory");
        }
        __syncthreads();
        if (t < 256) { const float* sp8 = ss + (size_t)(u.pm * BM + t) * 8; float tot = 0.f;
#pragma unroll
            for (int j = 0; j < 8; ++j) tot += __hip_atomic_load(sp8 + j, __ATOMIC_RELAXED, __HIP_MEMORY_SCOPE_AGENT);
            R[t] = 1.0f / sqrtf(tot * (1.0f / D_) + EPS); }
        __syncthreads();
        f32x4 wv[2][2];
#pragma unroll
        for (int bj = 0; bj < 2; ++bj) { wv[bj][0] = *(const f32x4*)(w + col0 + bj * HALF); wv[bj][1] = *(const f32x4*)(w + col0 + bj * HALF + 4); }
#pragma unroll
        for (int ai = 0; ai < 2; ++ai)
#pragma unroll
            for (int m = 0; m < 4; ++m) { const int rl = ai * HALF + wr * 64 + m * 16 + fr; const size_t off = (size_t)(u.pm * BM + rl) * ldc + col0; const float rs = R[rl];
#pragma unroll
                for (int bj = 0; bj < 2; ++bj) { *(f32x4*)(out + off + bj * HALF) = acc[ai][bj][m][0] * rs * wv[bj][0]; *(f32x4*)(out + off + bj * HALF + 4) = acc[ai][bj][m][1] * rs * wv[bj][1]; } }
        __syncthreads();
    }
};

template <class Epi, class Sched, bool ALIGN_EPI = false, bool SP2 = false>
__device__ __forceinline__ void gemm_phase(LAS unsigned char* lds, const Gemm g, const Sched& S, const Epi& E) {
    const int tid = threadIdx.x, wid = __builtin_amdgcn_readfirstlane(tid >> 6), lane = tid & 63, wr = wid >> 2, wc = wid & 3, fr = lane & 15, fq = lane >> 4;
    const int K = g.K, nt = K / BK;
    unsigned voffA[2], voffB[2];
#pragma unroll
    for (int i = 0; i < 2; ++i) { int R, C; stage_rc(tid * 16 + i * 8192, R, C); const int Rb = Epi::PERM ? ((R & ~31) + perm32(R & 31)) : R;
        voffA[i] = (unsigned)(R * K + C) * 2u; voffB[i] = (unsigned)(Rb * K + C) * 2u; }
    const size_t kstep = (size_t)(BK * 2);
    const size_t hstep = (size_t)HALF * K * 2;
    const size_t tstep = 2 * hstep;
    const unsigned ldsw = (unsigned)wid * 1024u;
    const int aoff = lds_byte(wr * 64 + fr, fq * 8), boff = lds_byte(wc * 32 + fr, fq * 8);
#define PG8_SA(b, h) (((b) * 2 + (h)) * HTB)
#define PG8_SB(b, h) ((4 + (b) * 2 + (h)) * HTB)
#define PG8_STAGE(bufoff, gbase, voff) do { _Pragma("unroll") for (int _i = 0; _i < 2; ++_i) \
        __builtin_amdgcn_global_load_lds((const unsigned*)((const char*)(gbase) + (voff)[_i]), (LAS unsigned*)(lds + (bufoff) + ldsw + _i * 8192), 16, 0, 0); } while (0)
#define PG8_LDA(dst, b, h) do { _Pragma("unroll") for (int m = 0; m < 4; ++m) _Pragma("unroll") for (int k = 0; k < 2; ++k) dst[m][k] = *(const LAS bf16x8*)(lds + PG8_SA(b, h) + aoff + m * 2048 + k * 1024); } while (0)
#define PG8_LDB(dst, b, h) do { _Pragma("unroll") for (int n = 0; n < 2; ++n) _Pragma("unroll") for (int k = 0; k < 2; ++k) dst[n][k] = *(const LAS bf16x8*)(lds + PG8_SB(b, h) + boff + n * 2048 + k * 1024); } while (0)
#define PG8_MMA(ai, bj, At, Bt) do { __builtin_amdgcn_s_setprio(1); _Pragma("unroll") for (int m = 0; m < 4; ++m) _Pragma("unroll") for (int n = 0; n < 2; ++n) _Pragma("unroll") for (int k = 0; k < 2; ++k) \
        acc[ai][bj][m][n] = __builtin_amdgcn_mfma_f32_16x16x32_bf16(Bt[n][k], At[m][k], acc[ai][bj][m][n], 0, 0, 0); __builtin_amdgcn_s_setprio(0); } while (0)
#define PG8_WAIT_V(n) asm volatile("s_waitcnt vmcnt(" #n ")" ::: "memory")
#define PG8_WAIT_L(n) asm volatile("s_waitcnt lgkmcnt(" #n ")" ::: "memory")
#define PG8_BAR __builtin_amdgcn_s_barrier()
#define PG8_SCHED __builtin_amdgcn_sched_barrier(0)
    Unit cur, nxt; int ui = 0;
    if (!S.next(0, cur)) return;
    f32x4 acc[2][2][4][2];
#pragma unroll
    for (int a = 0; a < 2; ++a)
#pragma unroll
        for (int b = 0; b < 2; ++b)
#pragma unroll
            for (int m = 0; m < 4; ++m)
#pragma unroll
                for (int n = 0; n < 2; ++n) acc[a][b][m][n] = (f32x4){0.f, 0.f, 0.f, 0.f};
    bf16x8 At[4][2], B0[2][2], B1[2][2];
    const char* cA = (const char*)g.A + (size_t)cur.pm * tstep; const char* cB = (const char*)g.Bt + (size_t)cur.pn * tstep;
    if constexpr (SP2) {
        PG8_STAGE(PG8_SB(0, 0), cB, voffB); PG8_STAGE(PG8_SB(0, 1), cB + hstep, voffB); PG8_STAGE(PG8_SA(0, 0), cA, voffA); PG8_STAGE(PG8_SA(0, 1), cA + hstep, voffA);
        if (wr == 1) PG8_BAR;
        PG8_WAIT_V(2); PG8_BAR;
        PG8_STAGE(PG8_SB(1, 0), cB + kstep, voffB); PG8_STAGE(PG8_SA(1, 0), cA + kstep, voffA); PG8_STAGE(PG8_SB(1, 1), cB + hstep + kstep, voffB);
        PG8_WAIT_V(6); PG8_BAR;
    } else {
        PG8_STAGE(PG8_SB(0, 0), cB, voffB); PG8_STAGE(PG8_SA(0, 0), cA, voffA); PG8_STAGE(PG8_SB(0, 1), cB + hstep, voffB); PG8_STAGE(PG8_SA(0, 1), cA + hstep, voffA);
        if (wr == 1) PG8_BAR;
        PG8_WAIT_V(4); PG8_BAR;
        PG8_STAGE(PG8_SB(1, 0), cB + kstep, voffB); PG8_STAGE(PG8_SA(1, 0), cA + kstep, voffA); PG8_STAGE(PG8_SB(1, 1), cB + hstep + kstep, voffB);
        PG8_WAIT_V(6); PG8_BAR;
    }
    for (;;) {
        const bool has_next = S.next(ui + 1, nxt);
        const char* nA = has_next ? (const char*)g.A + (size_t)nxt.pm * tstep : cA; const char* nB = has_next ? (const char*)g.Bt + (size_t)nxt.pn * tstep : cB;
        for (int t = 0; t < nt; t += 2) {
            const bool last = (t == nt - 2);
            const char* a1 = cA + (size_t)(t + 1) * kstep;
            const char* a2 = last ? nA : cA + (size_t)(t + 2) * kstep; const char* b2 = last ? nB : cB + (size_t)(t + 2) * kstep;
            const char* a3 = a2 + kstep; const char* b3 = b2 + kstep;
            if constexpr (SP2) {
            PG8_LDB(B0, 0, 0); PG8_LDB(B1, 0, 1); PG8_SCHED; PG8_LDA(At, 0, 0); PG8_STAGE(PG8_SA(1, 1), a1 + hstep, voffA);
            PG8_WAIT_V(8); PG8_WAIT_L(0); PG8_BAR; PG8_MMA(0, 0, At, B0); PG8_MMA(0, 1, At, B1); PG8_BAR; PG8_SCHED;
            PG8_LDA(At, 0, 1); PG8_STAGE(PG8_SB(0, 0), b2, voffB); PG8_STAGE(PG8_SB(0, 1), b2 + hstep, voffB); PG8_STAGE(PG8_SA(0, 0), a2, voffA);
            PG8_WAIT_V(8); PG8_WAIT_L(0); PG8_BAR; PG8_MMA(1, 0, At, B0); PG8_MMA(1, 1, At, B1); PG8_BAR; PG8_SCHED;
            PG8_LDB(B0, 1, 0); PG8_LDB(B1, 1, 1); PG8_SCHED; PG8_LDA(At, 1, 0); PG8_STAGE(PG8_SA(0, 1), a2 + hstep, voffA);
            PG8_WAIT_V(8); PG8_WAIT_L(0); PG8_BAR; PG8_MMA(0, 0, At, B0); PG8_MMA(0, 1, At, B1); PG8_BAR; PG8_SCHED;
            PG8_LDA(At, 1, 1); PG8_STAGE(PG8_SB(1, 0), b3, voffB); PG8_STAGE(PG8_SB(1, 1), b3 + hstep, voffB); PG8_STAGE(PG8_SA(1, 0), a3, voffA);
            PG8_WAIT_V(8); PG8_WAIT_L(0); PG8_BAR; PG8_MMA(1, 0, At, B0); PG8_MMA(1, 1, At, B1); PG8_BAR; PG8_SCHED;
            } else {
            PG8_LDB(B0, 0, 0); PG8_SCHED; PG8_LDA(At, 0, 0); PG8_STAGE(PG8_SA(1, 1), a1 + hstep, voffA);
            PG8_WAIT_L(8); PG8_BAR; PG8_WAIT_L(0); PG8_MMA(0, 0, At, B0); PG8_BAR; PG8_SCHED;
            PG8_LDB(B1, 0, 1); PG8_STAGE(PG8_SB(0, 0), b2, voffB);
            PG8_BAR; PG8_WAIT_L(0); PG8_MMA(0, 1, At, B1); PG8_BAR;
            PG8_LDA(At, 0, 1); PG8_STAGE(PG8_SA(0, 0), a2, voffA);
            PG8_BAR; PG8_WAIT_L(0); PG8_MMA(1, 0, At, B0); PG8_BAR; PG8_SCHED;
            PG8_STAGE(PG8_SB(0, 1), b2 + hstep, voffB);
            PG8_WAIT_V(6); PG8_BAR; PG8_MMA(1, 1, At, B1); PG8_BAR;
            PG8_LDB(B0, 1, 0); PG8_SCHED; PG8_LDA(At, 1, 0); PG8_STAGE(PG8_SA(0, 1), a2 + hstep, voffA);
            PG8_WAIT_L(8); PG8_BAR; PG8_WAIT_L(0); PG8_MMA(0, 0, At, B0); PG8_BAR; PG8_SCHED;
            PG8_LDB(B1, 1, 1); PG8_STAGE(PG8_SB(1, 0), b3, voffB);
            PG8_BAR; PG8_WAIT_L(0); PG8_MMA(0, 1, At, B1); PG8_BAR;
            PG8_LDA(At, 1, 1); PG8_STAGE(PG8_SA(1, 0), a3, voffA);
            PG8_BAR; PG8_WAIT_L(0); PG8_MMA(1, 0, At, B0); PG8_BAR; PG8_SCHED;
            PG8_STAGE(PG8_SB(1, 1), b3 + hstep, voffB);
            PG8_WAIT_V(6); PG8_BAR; PG8_MMA(1, 1, At, B1); PG8_BAR;
            }
        }
        if constexpr (ALIGN_EPI) { if (wr == 0) PG8_BAR; }
        if constexpr (!Epi::AFTER_DRAIN) { E(acc, cur, wr, wc, fr, fq); }
        if (!has_next) break;
#pragma unroll
        for (int a = 0; a < 2; ++a)
#pragma unroll
            for (int b = 0; b < 2; ++b)
#pragma unroll
                for (int m = 0; m < 4; ++m)
#pragma unroll
                    for (int n = 0; n < 2; ++n) acc[a][b][m][n] = (f32x4){0.f, 0.f, 0.f, 0.f};
        cur = nxt; cA = nA; cB = nB; ++ui;
        if constexpr (ALIGN_EPI) { if (wr == 1) PG8_BAR; }
    }
    PG8_WAIT_V(0);
    if constexpr (!ALIGN_EPI) { if (wr == 0) PG8_BAR; }
    PG8_BAR;
    if constexpr (Epi::AFTER_DRAIN) { E.fused(acc, cur, wr, wc, fr, fq, lds, wid, lane); }
#undef PG8_SA
#undef PG8_SB
#undef PG8_STAGE
#undef PG8_LDA
#undef PG8_LDB
#undef PG8_MMA
#undef PG8_WAIT_V
#undef PG8_WAIT_L
#undef PG8_BAR
#undef PG8_SCHED
}
}


#define XB_TMO      128
#define XB_XCNT(j)  (256  + 64 * (j))
#define XB_XSUB(j)  (1280 + 64 * (j))
#define XB_XGEN(j)  (2304 + 64 * (j))
#define XB_TOP      3328
#define XB_TOPGEN   3392
#define XCD_BAR_WORDS 3456
#define XB_SPIN_CAP (1u << 22)
__device__ __forceinline__ unsigned xb_ld(unsigned* p)              { return __hip_atomic_load(p, __ATOMIC_RELAXED, __HIP_MEMORY_SCOPE_AGENT); }
__device__ __forceinline__ unsigned xb_add(unsigned* p, unsigned v) { return __hip_atomic_fetch_add(p, v, __ATOMIC_RELAXED, __HIP_MEMORY_SCOPE_AGENT); }
__device__ __forceinline__ unsigned xb_xcc_id() { return (unsigned)__builtin_amdgcn_s_getreg((3 << 11) | 20) & 0xFu; }
#define XB_SPIN(cond, bar) do { unsigned _sp = 0; while (cond) { __builtin_amdgcn_s_sleep(1); \
    if ((++_sp & 255u) == 0u) { if (xb_ld(&(bar)[XB_TMO])) break; if (_sp > XB_SPIN_CAP) { atomicAdd(&(bar)[XB_TMO], 1u); break; } } } } while (0)
struct XcdBarrier { unsigned* bar; unsigned x; volatile LAS unsigned* st; };
__device__ __forceinline__ XcdBarrier xcd_barrier_post(unsigned* bar, volatile LAS unsigned* st) {
    XcdBarrier b; b.bar = bar; b.x = xb_xcc_id(); b.st = st;
    if (threadIdx.x == 0) (void)xb_add(&bar[XB_XCNT(b.x)], 1u);
    return b;
}
__device__ __forceinline__ void xcd_barrier_complete(unsigned* bar, unsigned x, unsigned& nloc, unsigned& nx) {
    const unsigned G = gridDim.x * gridDim.y * gridDim.z;
    unsigned sum, cnt, mine, sp = 0u;
    for (;;) {
        sum = 0u; cnt = 0u; mine = 0u;
#pragma unroll
        for (unsigned j = 0; j < 16; ++j) { const unsigned c = xb_ld(&bar[XB_XCNT(j)]); sum += c; cnt += (c > 0u) ? 1u : 0u; mine = (j == x) ? c : mine; }
        if (sum == G) break;
        __builtin_amdgcn_s_sleep(1);
        if ((++sp & 255u) == 0u) { if (xb_ld(&bar[XB_TMO])) break; if (sp > XB_SPIN_CAP) { atomicAdd(&bar[XB_TMO], 1u); break; } }
    }
    nloc = mine > 0u ? mine : 1u; nx = cnt > 0u ? cnt : 1u;
}
__device__ __forceinline__ void xcd_barrier(const XcdBarrier& b) {
    asm volatile("s_waitcnt vmcnt(0)" ::: "memory");
    __syncthreads();
    if (threadIdx.x == 0) {
        unsigned* bar = b.bar;
        __builtin_amdgcn_s_waitcnt(0);
        unsigned nloc = b.st[0], nx = b.st[1];
        if (nloc == 0u) { xcd_barrier_complete(bar, b.x, nloc, nx); b.st[0] = nloc; b.st[1] = nx; }
        const unsigned old = xb_add(&bar[XB_XSUB(b.x)], 1u);
        const unsigned gen = old / nloc;
        if (old + 1u == (gen + 1u) * nloc) {
            __builtin_amdgcn_fence(__ATOMIC_RELEASE, "agent");
            asm volatile("s_waitcnt vmcnt(0)" ::: "memory");
            const unsigned og = xb_add(&bar[XB_TOP], 1u);
            const unsigned tg = og / nx;
            if (og + 1u == (tg + 1u) * nx) xb_add(&bar[XB_TOPGEN], 1u);
            else XB_SPIN(xb_ld(&bar[XB_TOPGEN]) == tg, bar);
            __builtin_amdgcn_fence(__ATOMIC_ACQUIRE, "agent");
            xb_add(&bar[XB_XGEN(b.x)], 1u);
            asm volatile("s_waitcnt vmcnt(0)" ::: "memory");
        } else {
            XB_SPIN(xb_ld(&bar[XB_XGEN(b.x)]) == gen, bar);
            __builtin_amdgcn_fence(__ATOMIC_ACQUIRE, "agent");
            asm volatile("s_waitcnt vmcnt(0)" ::: "memory");
        }
    }
    __syncthreads();
}

struct Args { const float* in[17]; float* out; unsigned char* ws; int ph_lo, ph_hi; };
struct Ctx {
    LAS unsigned char* lds; int tid, lane, wave, G, bid;
    const float *x, *ln1, *w_in, *conv_w, *conv_b, *ga_w, *ga_b, *gx_w, *gx_b, *lam, *gn_w, *w_out, *ln2, *w_g, *w_u, *w_d, *fnw;
    float* out; unsigned char* ws;
};

struct TDesc { const float* W; bf16_t* WT; const float* ks; int K, N, mode, item; };
__device__ __forceinline__ void t_load(const TDesc& d, int lane, float (&v)[32], f32x4& s0, f32x4& s1) {
    const int nblk = d.N >> 5, kb = d.item / nblk, nb = d.item - kb * nblk, k0 = 64 * kb, n0 = 32 * nb;
    const float* p = d.W + (size_t)(k0 + (lane >> 5)) * d.N + n0 + (lane & 31);
    const size_t rs2 = (size_t)2 * d.N;
#pragma unroll
    for (int i = 0; i < 32; ++i) v[i] = p[i * rs2];
    s0 = (f32x4){1.f, 1.f, 1.f, 1.f}; s1 = s0;
    if (d.ks) { const float* kp = d.ks + k0 + 8 * (lane & 7); s0 = *(const f32x4*)kp; s1 = *(const f32x4*)(kp + 4); }
}
__device__ __forceinline__ void t_store(const TDesc& d, int lane, const float (&v)[32], const f32x4 s0, const f32x4 s1, LAS float* scr) {
    const int nblk = d.N >> 5, kb = d.item / nblk, nb = d.item - kb * nblk, k0 = 64 * kb, n0 = 32 * nb;
#pragma unroll
    for (int i = 0; i < 32; ++i) { const int kk = 2 * i + (lane >> 5); scr[kk * 33 + (lane & 31)] = v[i]; }
    asm volatile("s_waitcnt lgkmcnt(0)" ::: "memory");
    const int c = lane & 7;
#pragma unroll
    for (int j = 0; j < 4; ++j) { const int n = (lane >> 3) + 8 * j; const LAS float* s = scr + (8 * c) * 33 + n;
        u32x4 o; o.x = pk2(s[0 * 33] * s0[0], s[1 * 33] * s0[1]); o.y = pk2(s[2 * 33] * s0[2], s[3 * 33] * s0[3]); o.z = pk2(s[4 * 33] * s1[0], s[5 * 33] * s1[1]); o.w = pk2(s[6 * 33] * s1[2], s[7 * 33] * s1[3]);
        const int ng = n0 + n;
        int drow = ng;
        if (d.mode == 1) drow = (ng >> 7) * 256 + (ng & 127);
        else if (d.mode == 2) drow = (ng >> 7) * 256 + 128 + (ng & 127);
        *(u32x4*)(d.WT + (size_t)drow * d.K + k0 + 8 * c) = o; }
    asm volatile("s_waitcnt lgkmcnt(0)" ::: "memory");
}
__device__ __forceinline__ bool p0_desc(const Ctx& F, int part, int it, TDesc& d) {
    constexpr int I_IN = (D_ / 64) * (DIN / 32), I_OUT = (D_ / 64) * (D_ / 32), I_G = (D_ / 64) * (DFF / 32), I_D = (DFF / 64) * (D_ / 32), I_LG = 8 * 2 * 4;
    d.ks = nullptr; d.mode = 0;
    if (part == 0) {
        if (it >= I_IN + 2 * I_LG) return false;
        int r = it;
        if (r < I_IN) { d.W = F.w_in; d.WT = (bf16_t*)(F.ws + WS_WIN); d.ks = F.ln1; d.K = D_; d.N = DIN; d.item = r; return true; } r -= I_IN;
        const bool isx = r >= I_LG; if (isx) r -= I_LG;
        const int blk = r >> 3;
        d.W = (isx ? F.gx_w : F.ga_w) + (size_t)blk * 16384; d.WT = (bf16_t*)(F.ws + (isx ? WS_GXT : WS_GAT)) + (size_t)blk * 16384; d.K = 128; d.N = 128; d.item = r & 7; return true;
    } else if (part == 1) {
        if (it >= I_OUT + 2 * I_G) return false;
        int r = it;
        if (r < I_OUT) { d.W = F.w_out; d.WT = (bf16_t*)(F.ws + WS_WOUT); d.K = D_; d.N = D_; d.item = r; return true; } r -= I_OUT;
        const bool isu = r >= I_G; if (isu) r -= I_G;
        d.W = isu ? F.w_u : F.w_g; d.WT = (bf16_t*)(F.ws + WS_WGU); d.ks = F.ln2; d.K = D_; d.N = DFF; d.mode = isu ? 2 : 1; d.item = r; return true;
    }
    if (it >= I_D) return false;
    d.W = F.w_d; d.WT = (bf16_t*)(F.ws + WS_WD); d.K = DFF; d.N = D_; d.item = it; return true;
}
__device__ __forceinline__ void x_load(const Ctx& F, int m, f32x4 (&v)[8]) {
    const f32x4* xr = (const f32x4*)(F.x + (size_t)m * D_) + F.lane;
#pragma unroll
    for (int j = 0; j < 8; ++j) v[j] = xr[64 * j];
}
__device__ __forceinline__ void x_store(const Ctx& F, int m, const f32x4 (&v)[8]) {
    float s = 0.f;
#pragma unroll
    for (int j = 0; j < 8; ++j) s += (v[j][0] * v[j][0] + v[j][1] * v[j][1]) + (v[j][2] * v[j][2] + v[j][3] * v[j][3]);
    s = wave_sum(s);
    if (F.lane == 0) ((float*)(F.ws + WS_RSTD1))[m] = 1.0f / sqrtf(s * (1.0f / D_) + EPS);
    u32x2* o8 = (u32x2*)((bf16_t*)F.out + (size_t)m * D_) + F.lane;
#pragma unroll
    for (int j = 0; j < 8; ++j) { u32x2 w; w.x = pk2(v[j][0], v[j][1]); w.y = pk2(v[j][2], v[j][3]); o8[64 * j] = w; }
}
__device__ __forceinline__ void p0_prologue(Ctx& F, int part, int gw, int NGW) {
    LAS float* scr = (LAS float*)(F.lds + F.wave * 8704);
    {
        TDesc dA, dB; float vA[32], vB[32]; f32x4 a0, a1, b0, b1;
        int it = gw;
        bool hA = p0_desc(F, part, it, dA);
        if (hA) t_load(dA, F.lane, vA, a0, a1);
        while (hA) {
            const bool hB = p0_desc(F, part, it + NGW, dB);
            if (hB) t_load(dB, F.lane, vB, b0, b1);
            t_store(dA, F.lane, vA, a0, a1, scr);
            if (!hB) break;
            hA = p0_desc(F, part, it + 2 * NGW, dA);
            if (hA) t_load(dA, F.lane, vA, a0, a1);
            t_store(dB, F.lane, vB, b0, b1, scr);
            it += 2 * NGW;
        }
    }
    if (part != 0) return;
    {
        f32x4 vA[8], vB[8];
        int m = gw;
        if (m < S_) x_load(F, m, vA);
        while (m < S_) {
            const int mb = m + NGW;
            if (mb < S_) x_load(F, mb, vB);
            x_store(F, m, vA);
            if (mb >= S_) break;
            m = mb + NGW;
            if (m < S_) x_load(F, m, vA);
            x_store(F, mb, vB);
        }
    }
}

template <bool FINAL>
__device__ __forceinline__ void p2_lru(Ctx& F, int cpart, int cbase, int cstep, int cslots) {
    const bf16_t* proj = (const bf16_t*)(F.ws + WS_PROJ);
    const bf16_t* GaT = (const bf16_t*)(F.ws + WS_GAT); const bf16_t* GxT = (const bf16_t*)(F.ws + WS_GXT);
    float* Atot = (float*)(F.ws + WS_ATOT); float* Hend = (float*)(F.ws + WS_HEND);
    const float* carry = (const float*)(F.ws + WS_CARRY); bf16_t* Y = (bf16_t*)(F.ws + WS_Y);
    LAS float* XC = (LAS float*)F.lds;
    LAS float* HB = (LAS float*)(F.lds + 33792);
    LAS bf16_t* HL = (LAS bf16_t*)(F.lds + 33792); LAS bf16_t* PL = (LAS bf16_t*)(F.lds + 51200);
    bf16_t* hlocB = (bf16_t*)F.out + (size_t)S_ * D_; bf16_t* pcumB = hlocB + (size_t)S_ * DLRU;
    const int w = F.wave, lane = F.lane, r16 = lane & 15, g4 = lane >> 4;
    int curn = -1; bf16x8 Ba[4], Bx[4]; float bar = 0.f, bxr = 0.f, kch = 0.f;
    float cw0[4] = {0.f, 0.f, 0.f, 0.f}, cw1[4] = {0.f, 0.f, 0.f, 0.f}; f32x2 cb = (f32x2){0.f, 0.f};
    unsigned xn[11];
    { const int it0 = F.bid; const int n0 = it0 & 7, tb = (it0 >> 3) * LCH + w * 8 - 3;
#pragma unroll
      for (int i = 0; i < 11; ++i) { const int t = tb + i; xn[i] = 0u; if (it0 < NLCH * 8 && t >= 0) xn[i] = *(const unsigned*)(proj + (size_t)t * DIN + n0 * 128 + 2 * lane); } }
    LAS float* cscr = (LAS float*)(F.lds + 69632 + w * 8704);
    int slot = 0;
    for (int it = F.bid; it < NLCH * 8; it += F.G, ++slot) {
        const int n = it & 7, chunk = it >> 3, t0 = chunk * LCH;
        const int chl = 16 * w + r16, ch = n * 128 + chl;
        TDesc cd; float cv[32]; f32x4 cs0, cs1;
        const bool hc = (slot < cslots) && p0_desc(F, cpart, cbase + slot * cstep, cd);
        if (n != curn) { curn = n;
#pragma unroll
            for (int kk = 0; kk < 4; ++kk) { Ba[kk] = *(const bf16x8*)(GaT + ((size_t)n * 128 + chl) * 128 + 32 * kk + 8 * g4); Bx[kk] = *(const bf16x8*)(GxT + ((size_t)n * 128 + chl) * 128 + 32 * kk + 8 * g4); }
            bar = F.ga_b[ch]; bxr = F.gx_b[ch];
            const float lm = F.lam[ch]; const float logsig = -log1pf(expf(-lm));
            kch = 8.0f * logsig;
#pragma unroll
            for (int k = 0; k < 4; ++k) { const f32x2 c2 = *(const f32x2*)(F.conv_w + k * DLRU + n * 128 + 2 * lane); cw0[k] = c2[0]; cw1[k] = c2[1]; }
            cb = *(const f32x2*)(F.conv_b + n * 128 + 2 * lane);
        }
        const int etok = F.tid >> 3, ec16 = (F.tid & 7) * 16;
        u32x4 gq0 = (u32x4){0u, 0u, 0u, 0u}, gq1 = gq0; float Hc = 0.f;
        if constexpr (FINAL) { const bf16_t* gp = proj + (size_t)(t0 + etok) * DIN + DLRU + n * 128 + ec16; gq0 = *(const u32x4*)gp; gq1 = *(const u32x4*)(gp + 8); Hc = carry[chunk * DLRU + ch]; }
        { const int cp = lane, tg = w;
          float xw0[11], xw1[11];
#pragma unroll
          for (int i = 0; i < 11; ++i) { xw0[i] = bf_lo(xn[i]); xw1[i] = bf_hi(xn[i]); }
#pragma unroll
          for (int j = 0; j < 8; ++j) { float y0 = cb[0], y1 = cb[1];
#pragma unroll
              for (int k = 0; k < 4; ++k) { y0 += cw0[k] * xw0[j + k]; y1 += cw1[k] * xw1[j + k]; }
              *(LAS f32x2*)(XC + (tg * 8 + j) * 132 + 2 * cp) = (f32x2){y0, y1}; }
        }
        __syncthreads();
        { const int itn = it + F.G; const int nn = itn & 7, tb = (itn >> 3) * LCH + w * 8 - 3;
          if (itn < NLCH * 8) {
#pragma unroll
            for (int i = 0; i < 11; ++i) xn[i] = *(const unsigned*)(proj + (size_t)(tb + i) * DIN + nn * 128 + 2 * lane); } }
        if (hc) t_load(cd, lane, cv, cs0, cs1);
        float Pc = 1.f;
#pragma unroll
        for (int m = 0; m < 4; ++m) {
            f32x4 ar = (f32x4){0.f, 0.f, 0.f, 0.f}, ax = (f32x4){0.f, 0.f, 0.f, 0.f};
#pragma unroll
            for (int kk = 0; kk < 4; ++kk) { const LAS float* xr = XC + (16 * m + r16) * 132 + 32 * kk + 8 * g4;
                const f32x4 x0 = *(const LAS f32x4*)xr, x1 = *(const LAS f32x4*)(xr + 4);
                u32x4 pw; pw.x = pk2(x0[0], x0[1]); pw.y = pk2(x0[2], x0[3]); pw.z = pk2(x1[0], x1[1]); pw.w = pk2(x1[2], x1[3]);
                const bf16x8 af = __builtin_bit_cast(bf16x8, pw);
                ar = __builtin_amdgcn_mfma_f32_16x16x32_bf16(af, Ba[kk], ar, 0, 0, 0);
                ax = __builtin_amdgcn_mfma_f32_16x16x32_bf16(af, Bx[kk], ax, 0, 0, 0); }
            float P[4], H[4];
#pragma unroll
            for (int jj = 0; jj < 4; ++jj) { const int tok = 16 * m + 4 * g4 + jj;
                const float xc = XC[tok * 132 + chl];
                const float r = sigm(ar[jj] + bar), ig = sigm(ax[jj] + bxr);
                const float la = kch * r;
                const float a = __builtin_amdgcn_exp2f(la * 1.4426950408889634f);
                const float z = 2.0f * la;
                const float om = z > -4e-3f ? -z * (1.f + z * (0.5f + z * (1.f / 6.f))) : __builtin_fmaf(-a, a, 1.0f);
                const float b = __builtin_amdgcn_sqrtf(fmaxf(om, 0.f)) * (ig * xc);
                if (jj == 0) { P[0] = a; H[0] = b; } else { P[jj] = a * P[jj - 1]; H[jj] = a * H[jj - 1] + b; } }
            float Pt = P[3], Ht = H[3];
            float Pq = __shfl_up(Pt, 16), Hq = __shfl_up(Ht, 16); if (g4 >= 1) { Ht = Pt * Hq + Ht; Pt = Pt * Pq; }
            Pq = __shfl_up(Pt, 32); Hq = __shfl_up(Ht, 32); if (g4 >= 2) { Ht = Pt * Hq + Ht; Pt = Pt * Pq; }
            float Pe = __shfl_up(Pt, 16), He = __shfl_up(Ht, 16); if (g4 == 0) { Pe = 1.f; He = 0.f; }
            if constexpr (FINAL) {
                const float Hpre = Pe * Hc + He;
#pragma unroll
                for (int jj = 0; jj < 4; ++jj) HB[(16 * m + 4 * g4 + jj) * 132 + chl] = P[jj] * Hpre + H[jj];
            } else {
                const float Hpre = Pe * Hc + He, Ppre = Pe * Pc;
#pragma unroll
                for (int jj = 0; jj < 4; ++jj) { const unsigned hp = pk2(P[jj] * Hpre + H[jj], P[jj] * Ppre);
                    HL[(16 * m + 4 * g4 + jj) * 136 + chl] = (bf16_t)(hp & 0xffffu); PL[(16 * m + 4 * g4 + jj) * 136 + chl] = (bf16_t)(hp >> 16); }
            }
            const float Ptile = __shfl(Pt, r16 + 48), Htile = __shfl(Ht, r16 + 48);
            Hc = Ptile * Hc + Htile; Pc = Ptile * Pc;
        }
        if constexpr (!FINAL) { if (g4 == 0) { Atot[chunk * DLRU + ch] = Pc; Hend[chunk * DLRU + ch] = Hc; } }
        __syncthreads();
        if constexpr (!FINAL) {
            const size_t go = (size_t)(t0 + etok) * DLRU + n * 128 + ec16;
            const u32x4 h0 = *(const LAS u32x4*)(HL + etok * 136 + ec16), h1 = *(const LAS u32x4*)(HL + etok * 136 + ec16 + 8);
            const u32x4 p0 = *(const LAS u32x4*)(PL + etok * 136 + ec16), p1 = *(const LAS u32x4*)(PL + etok * 136 + ec16 + 8);
            *(u32x4*)(hlocB + go) = h0; *(u32x4*)(hlocB + go + 8) = h1; *(u32x4*)(pcumB + go) = p0; *(u32x4*)(pcumB + go + 8) = p1;
        }
        if constexpr (FINAL) {
            const LAS float* hr = HB + etok * 132 + ec16;
            float hv[16], g[16];
#pragma unroll
            for (int q = 0; q < 4; ++q) { const f32x4 v = *(const LAS f32x4*)(hr + 4 * q); hv[4 * q] = v[0]; hv[4 * q + 1] = v[1]; hv[4 * q + 2] = v[2]; hv[4 * q + 3] = v[3]; }
#pragma unroll
            for (int q = 0; q < 4; ++q) { g[2 * q] = bf_lo(gq0[q]); g[2 * q + 1] = bf_hi(gq0[q]); g[8 + 2 * q] = bf_lo(gq1[q]); g[8 + 2 * q + 1] = bf_hi(gq1[q]); }
            float o[16];
#pragma unroll
            for (int j = 0; j < 16; ++j) { const float u = 0.7978845608028654f * (g[j] + 0.044715f * g[j] * g[j] * g[j]); o[j] = hv[j] * g[j] * sigm(2.0f * u); }
            u32x4 w0, w1;
#pragma unroll
            for (int q = 0; q < 4; ++q) { w0[q] = pk2(o[2 * q], o[2 * q + 1]); w1[q] = pk2(o[8 + 2 * q], o[8 + 2 * q + 1]); }
            bf16_t* yo = Y + (size_t)(t0 + etok) * D_ + n * 128 + ec16;
            *(u32x4*)yo = w0; *(u32x4*)(yo + 8) = w1;
        }
        if (hc) t_store(cd, lane, cv, cs0, cs1, cscr);
    }
}

__device__ __forceinline__ void rope8(const u32x4 a, const u32x4 b, const f32x4 c0, const f32x4 c1, const f32x4 s0, const f32x4 s1, float scale, u32x4& oa, u32x4& ob) {
    float x1[8], x2[8], c[8], s[8], o1[8], o2[8];
#pragma unroll
    for (int i = 0; i < 4; ++i) { x1[2 * i] = bf_lo(a[i]); x1[2 * i + 1] = bf_hi(a[i]); x2[2 * i] = bf_lo(b[i]); x2[2 * i + 1] = bf_hi(b[i]); c[i] = c0[i]; c[4 + i] = c1[i]; s[i] = s0[i]; s[4 + i] = s1[i]; }
#pragma unroll
    for (int i = 0; i < 8; ++i) { o1[i] = (x1[i] * c[i] - x2[i] * s[i]) * scale; o2[i] = (x1[i] * s[i] + x2[i] * c[i]) * scale; }
#pragma unroll
    for (int i = 0; i < 4; ++i) { oa[i] = pk2(o1[2 * i], o1[2 * i + 1]); ob[i] = pk2(o2[2 * i], o2[2 * i + 1]); }
}
struct RopeC { float hi[16], lo[16]; };
__device__ __forceinline__ void rope_init(RopeC& R, int g4) {
#pragma unroll
    for (int j = 0; j < 16; ++j) { const int f = 32 * (j >> 3) + 8 * g4 + (j & 7);
        const double c = exp2(-(double)f * (13.287712379549449 / 64.0)) * 0.15915494309189535;
        const float hh = (float)c; R.hi[j] = hh; R.lo[j] = (float)(c - (double)hh); }
}
template <int K2>
__device__ __forceinline__ void rope_cs(const RopeC& R, float tpos, f32x4& c0, f32x4& c1, f32x4& s0, f32x4& s1) {
#pragma unroll
    for (int i = 0; i < 8; ++i) { const float hh = R.hi[K2 * 8 + i], p = tpos * hh, e = __builtin_fmaf(tpos, hh, -p);
        const float r = __builtin_amdgcn_fractf(p) + (e + tpos * R.lo[K2 * 8 + i]);
        const float cv = __builtin_amdgcn_cosf(r), sv = __builtin_amdgcn_sinf(r);
        if (i < 4) { c0[i] = cv; s0[i] = sv; } else { c1[i - 4] = cv; s1[i - 4] = sv; } }
}
__device__ __forceinline__ float log2gamma(int h) { return log1pf(-exp2f(-5.0f - (float)h)) * 1.4426950408889634f; }

__device__ __forceinline__ void p2_ret(Ctx& F) {
    const bf16_t* proj = (const bf16_t*)(F.ws + WS_PROJ);
    bf16_t* kvT = (bf16_t*)(F.ws + WS_KV);
    LAS bf16_t* KT = (LAS bf16_t*)F.lds;
    LAS bf16_t* VT = (LAS bf16_t*)(F.lds + 34816);
    const int w = F.wave, lane = F.lane, r16 = lane & 15, g4 = lane >> 4;
    const int tl = 16 * w + r16;
    RopeC RC; rope_init(RC, g4);
    u32x4 kc[4], vc[4];
#pragma unroll
    for (int kk = 0; kk < 4; ++kk) { kc[kk] = (u32x4){0u, 0u, 0u, 0u}; vc[kk] = kc[kk]; }
    if (F.bid < NRCH * 8) { const bf16_t* prow = proj + (size_t)((F.bid >> 3) * RCH + tl) * DIN + (F.bid & 7) * 128 + 8 * g4;
#pragma unroll
        for (int kk = 0; kk < 4; ++kk) { kc[kk] = *(const u32x4*)(prow + 3072 + 32 * kk); vc[kk] = *(const u32x4*)(prow + 4096 + 32 * kk); } }
    for (int it = F.bid; it < NRCH * 8; it += F.G) {
        const int h = it & 7, n = it >> 3, t0 = n * RCH;
        const float lg2 = log2gamma(h);
        u32x4 kr[4];
        { f32x4 c0, c1, s0, s1; const float tpos = (float)(t0 + tl);
          rope_cs<0>(RC, tpos, c0, c1, s0, s1); rope8(kc[0], kc[2], c0, c1, s0, s1, 0.08838834764831845f, kr[0], kr[2]);
          rope_cs<1>(RC, tpos, c0, c1, s0, s1); rope8(kc[1], kc[3], c0, c1, s0, s1, 0.08838834764831845f, kr[1], kr[3]); }
        const float zeta = __builtin_amdgcn_exp2f((float)(127 - tl) * lg2);
#pragma unroll
        for (int kk = 0; kk < 4; ++kk)
#pragma unroll
            for (int i = 0; i < 4; ++i) { const int d = 32 * kk + 8 * g4 + 2 * i;
                KT[d * 136 + tl] = (bf16_t)(kr[kk][i] & 0xffffu); KT[(d + 1) * 136 + tl] = (bf16_t)(kr[kk][i] >> 16);
                const unsigned vz = pk2(bf_lo(vc[kk][i]) * zeta, bf_hi(vc[kk][i]) * zeta);
                VT[d * 136 + tl] = (bf16_t)(vz & 0xffffu); VT[(d + 1) * 136 + tl] = (bf16_t)(vz >> 16); }
        __syncthreads();
        { const int itn = it + F.G;
          if (itn < NRCH * 8) { const bf16_t* prow = proj + (size_t)((itn >> 3) * RCH + tl) * DIN + (itn & 7) * 128 + 8 * g4;
#pragma unroll
            for (int kk = 0; kk < 4; ++kk) { kc[kk] = *(const u32x4*)(prow + 3072 + 32 * kk); vc[kk] = *(const u32x4*)(prow + 4096 + 32 * kk); } } }
        bf16x8 af[4];
#pragma unroll
        for (int kk = 0; kk < 4; ++kk) af[kk] = *(const LAS bf16x8*)(KT + (16 * w + r16) * 136 + 32 * kk + 8 * g4);
        bf16_t* dst = kvT + ((size_t)(n * 8 + h) * 128 + r16) * 128 + 16 * w + 4 * g4;
#pragma unroll
        for (int ne = 0; ne < 8; ++ne) { f32x4 acc = (f32x4){0.f, 0.f, 0.f, 0.f};
#pragma unroll
            for (int kk = 0; kk < 4; ++kk) { const bf16x8 bfr = *(const LAS bf16x8*)(VT + (16 * ne + r16) * 136 + 32 * kk + 8 * g4); acc = __builtin_amdgcn_mfma_f32_16x16x32_bf16(af[kk], bfr, acc, 0, 0, 0); }
            u32x2 o; o.x = pk2_sw(acc[0], acc[1]); o.y = pk2_sw(acc[2], acc[3]);
            *(u32x2*)(dst + (size_t)(16 * ne) * 128) = o; }
        __syncthreads();
    }
}

__device__ __forceinline__ void p3_carries(Ctx& F) {
    const int gw = F.wave * F.G + F.bid, NGW = F.G * NWAVES, lane = F.lane;
    const bf16_t* kvT = (const bf16_t*)(F.ws + WS_KV); bf16_t* Rp = (bf16_t*)(F.ws + WS_RP);
    const float* Atot = (const float*)(F.ws + WS_ATOT); const float* Hend = (const float*)(F.ws + WS_HEND); float* carry = (float*)(F.ws + WS_CARRY);
    constexpr int NRT = 8 * 128 * 128 / 128;
    constexpr int NLT = DLRU / 8;
    for (int task = gw; task < NRT + NLT; task += NGW) {
        if (task < NRT) {
            const int e2 = task * 128 + 2 * lane, h = e2 >> 14;
            const float gC = exp2f(128.0f * log2gamma(h));
            unsigned kv[NRCH];
#pragma unroll
            for (int j = 0; j < NRCH; ++j) kv[j] = *(const unsigned*)(kvT + (size_t)j * 131072 + e2);
            float r0 = 0.f, r1 = 0.f;
#pragma unroll
            for (int j = 0; j < NRCH; ++j) { *(unsigned*)(Rp + (size_t)j * 131072 + e2) = pk2(r0, r1); r0 = r0 * gC + bf_lo(kv[j]); r1 = r1 * gC + bf_hi(kv[j]); }
        } else {
            const int ch = (task - NRT) * 8 + (lane & 7), seg = lane >> 3, c0 = seg * 16;
            float av[16], hv[16];
#pragma unroll
            for (int j = 0; j < 16; ++j) { av[j] = Atot[(c0 + j) * DLRU + ch]; hv[j] = Hend[(c0 + j) * DLRU + ch]; }
            float A = 1.f, H = 0.f;
#pragma unroll
            for (int j = 0; j < 16; ++j) { H = av[j] * H + hv[j]; A = av[j] * A; }
#pragma unroll
            for (int o = 8; o < 64; o <<= 1) { const float Ap = __shfl_up(A, o), Hp = __shfl_up(H, o); if (lane >= o) { H = A * Hp + H; A = A * Ap; } }
            float Hc = __shfl_up(H, 8); if (seg == 0) Hc = 0.f;
#pragma unroll
            for (int j = 0; j < 16; ++j) { carry[(c0 + j) * DLRU + ch] = Hc; Hc = av[j] * Hc + hv[j]; }
        }
    }
}

__device__ __forceinline__ void p4_ret_preload(Ctx& F, u32x4 (&qc)[4], u32x4 (&kc)[4], u32x4 (&vc)[4], u32x4 (&gq)[4]) {
    const bf16_t* proj = (const bf16_t*)(F.ws + WS_PROJ);
    const int w = F.wave, lane = F.lane, r16 = lane & 15, g4 = lane >> 4, orow = lane >> 2, ocol = (lane & 3) * 32, tl = 16 * w + r16;
#pragma unroll
    for (int kk = 0; kk < 4; ++kk) { qc[kk] = (u32x4){0u, 0u, 0u, 0u}; kc[kk] = qc[kk]; vc[kk] = qc[kk]; gq[kk] = qc[kk]; }
    if (F.bid < NRCH * 8) { const int h0 = F.bid & 7, tb = (F.bid >> 3) * RCH;
        const bf16_t* prow = proj + (size_t)(tb + tl) * DIN + h0 * 128 + 8 * g4;
#pragma unroll
        for (int kk = 0; kk < 4; ++kk) { qc[kk] = *(const u32x4*)(prow + 2048 + 32 * kk); kc[kk] = *(const u32x4*)(prow + 3072 + 32 * kk); vc[kk] = *(const u32x4*)(prow + 4096 + 32 * kk); }
        const bf16_t* gp = proj + (size_t)(tb + 16 * w + orow) * DIN + 5120 + h0 * 128 + ocol;
#pragma unroll
        for (int i = 0; i < 4; ++i) gq[i] = *(const u32x4*)(gp + 8 * i); }
}
__device__ __forceinline__ void p4_ret(Ctx& F, u32x4 (&qc)[4], u32x4 (&kc)[4], u32x4 (&vc)[4], u32x4 (&gq)[4]) {
    const bf16_t* proj = (const bf16_t*)(F.ws + WS_PROJ); bf16_t* Y = (bf16_t*)(F.ws + WS_Y);
    const bf16_t* Rp = (const bf16_t*)(F.ws + WS_RP);
    LAS bf16_t* KS = (LAS bf16_t*)F.lds;
    LAS bf16_t* VT = (LAS bf16_t*)(F.lds + 34816);
    LAS unsigned char* RL = F.lds + 104448;
    const int w = F.wave, lane = F.lane, r16 = lane & 15, g4 = lane >> 4;
    LAS bf16_t* PS = (LAS bf16_t*)(F.lds + 69632) + w * (16 * 136);
    const int orow = lane >> 2, ocol = (lane & 3) * 32;
    const int tl = 16 * w + r16;
    RopeC RC; rope_init(RC, g4);
    for (int it = F.bid; it < NRCH * 8; it += F.G) {
        const int h = it & 7, n = it >> 3, t0 = n * RCH;
        const float lg2 = log2gamma(h);
        { const char* rg = (const char*)(Rp + (size_t)(n * 8 + h) * 16384);
#pragma unroll
          for (int i = 0; i < 4; ++i) { const int e = i * 32 + w * 4 + (lane >> 4), pos = lane & 15;
              __builtin_amdgcn_global_load_lds((const unsigned*)(rg + e * 256 + ((pos ^ (e & 15)) * 16)), (LAS unsigned*)(RL + i * 8192 + w * 1024), 16, 0, 0); } }
        u32x4 qf[4], go[4];
        {
            u32x4 kr[4];
            { f32x4 c0, c1, s0, s1; const float tpos = (float)(t0 + tl);
              rope_cs<0>(RC, tpos, c0, c1, s0, s1); rope8(qc[0], qc[2], c0, c1, s0, s1, 1.0f, qf[0], qf[2]); rope8(kc[0], kc[2], c0, c1, s0, s1, 0.08838834764831845f, kr[0], kr[2]);
              rope_cs<1>(RC, tpos, c0, c1, s0, s1); rope8(qc[1], qc[3], c0, c1, s0, s1, 1.0f, qf[1], qf[3]); rope8(kc[1], kc[3], c0, c1, s0, s1, 0.08838834764831845f, kr[1], kr[3]); }
#pragma unroll
            for (int kk = 0; kk < 4; ++kk) { *(LAS u32x4*)(KS + tl * 136 + 32 * kk + 8 * g4) = kr[kk];
#pragma unroll
                for (int i = 0; i < 4; ++i) { const int e = 32 * kk + 8 * g4 + 2 * i; VT[e * 136 + tl] = (bf16_t)(vc[kk][i] & 0xffffu); VT[(e + 1) * 136 + tl] = (bf16_t)(vc[kk][i] >> 16); } }
#pragma unroll
            for (int i = 0; i < 4; ++i) go[i] = gq[i];
        }
        asm volatile("s_waitcnt vmcnt(0)" ::: "memory");
        __syncthreads();
        { const int itn = it + F.G;
          if (itn < NRCH * 8) { const int hn = itn & 7, tb = (itn >> 3) * RCH;
            const bf16_t* prow = proj + (size_t)(tb + tl) * DIN + hn * 128 + 8 * g4;
#pragma unroll
            for (int kk = 0; kk < 4; ++kk) { qc[kk] = *(const u32x4*)(prow + 2048 + 32 * kk); kc[kk] = *(const u32x4*)(prow + 3072 + 32 * kk); vc[kk] = *(const u32x4*)(prow + 4096 + 32 * kk); }
            const bf16_t* gp = proj + (size_t)(tb + 16 * w + orow) * DIN + 5120 + hn * 128 + ocol;
#pragma unroll
            for (int i = 0; i < 4; ++i) gq[i] = *(const u32x4*)(gp + 8 * i); } }
#pragma unroll
        for (int nn = 0; nn < 8; ++nn) {
            if (nn <= w) {
                f32x4 acc = (f32x4){0.f, 0.f, 0.f, 0.f};
#pragma unroll
                for (int kk = 0; kk < 4; ++kk) { const bf16x8 kf = *(const LAS bf16x8*)(KS + (16 * nn + r16) * 136 + 32 * kk + 8 * g4); acc = __builtin_amdgcn_mfma_f32_16x16x32_bf16(__builtin_bit_cast(bf16x8, qf[kk]), kf, acc, 0, 0, 0); }
#pragma unroll
                for (int jj = 0; jj < 4; ++jj) { const int diff = (16 * w + 4 * g4 + jj) - (16 * nn + r16);
                    const float p = diff >= 0 ? acc[jj] * __builtin_amdgcn_exp2f((float)diff * lg2) : 0.f;
                    PS[(4 * g4 + jj) * 136 + 16 * nn + r16] = (bf16_t)(pk2(p, 0.f) & 0xffffu); }
            } else if (nn <= (w | 1)) {
#pragma unroll
                for (int jj = 0; jj < 4; ++jj) PS[(4 * g4 + jj) * 136 + 16 * nn + r16] = (bf16_t)0;
            }
        }
        asm volatile("s_waitcnt lgkmcnt(0)" ::: "memory");
        f32x4 O[8];
#pragma unroll
        for (int ne = 0; ne < 8; ++ne) O[ne] = (f32x4){0.f, 0.f, 0.f, 0.f};
#pragma unroll
        for (int k2 = 0; k2 < 4; ++k2) {
            if (k2 <= (w >> 1)) {
                const bf16x8 pf = *(const LAS bf16x8*)(PS + r16 * 136 + 32 * k2 + 8 * g4);
#pragma unroll
                for (int ne = 0; ne < 8; ++ne) { const bf16x8 vf = *(const LAS bf16x8*)(VT + (16 * ne + r16) * 136 + 32 * k2 + 8 * g4); O[ne] = __builtin_amdgcn_mfma_f32_16x16x32_bf16(pf, vf, O[ne], 0, 0, 0); }
            }
        }
        float xi[4];
#pragma unroll
        for (int jj = 0; jj < 4; ++jj) xi[jj] = __builtin_amdgcn_exp2f((float)(16 * w + 4 * g4 + jj + 1) * lg2);
#pragma unroll
        for (int ne = 0; ne < 8; ++ne) { f32x4 cx = (f32x4){0.f, 0.f, 0.f, 0.f};
#pragma unroll
            for (int kk = 0; kk < 4; ++kk) { const bf16x8 rf = *(const LAS bf16x8*)(RL + (16 * ne + r16) * 256 + (((4 * kk + g4) ^ r16) * 16)); cx = __builtin_amdgcn_mfma_f32_16x16x32_bf16(__builtin_bit_cast(bf16x8, qf[kk]), rf, cx, 0, 0, 0); }
#pragma unroll
            for (int jj = 0; jj < 4; ++jj) O[ne][jj] += xi[jj] * cx[jj]; }
        float gnw[8];
#pragma unroll
        for (int ne = 0; ne < 8; ++ne) gnw[ne] = F.gn_w[h * 128 + 16 * ne + r16];
#pragma unroll
        for (int jj = 0; jj < 4; ++jj) {
            float s = 0.f;
#pragma unroll
            for (int ne = 0; ne < 8; ++ne) s += O[ne][jj];
            s += __shfl_xor(s, 1); s += __shfl_xor(s, 2); s += __shfl_xor(s, 4); s += __shfl_xor(s, 8);
            const float mu = s * (1.0f / 128.0f); float q = 0.f;
#pragma unroll
            for (int ne = 0; ne < 8; ++ne) { const float d = O[ne][jj] - mu; q += d * d; }
            q += __shfl_xor(q, 1); q += __shfl_xor(q, 2); q += __shfl_xor(q, 4); q += __shfl_xor(q, 8);
            const float rstd = __builtin_amdgcn_rsqf(q * (1.0f / 128.0f) + EPS);
#pragma unroll
            for (int ne = 0; ne < 8; ++ne) { const float on = (O[ne][jj] - mu) * rstd * gnw[ne];
                PS[(4 * g4 + jj) * 136 + 16 * ne + r16] = (bf16_t)(pk2(on, 0.f) & 0xffffu); }
        }
        asm volatile("s_waitcnt lgkmcnt(0)" ::: "memory");
        { bf16_t* yo = Y + (size_t)(t0 + 16 * w + orow) * D_ + DLRU + h * 128 + ocol;
#pragma unroll
          for (int i = 0; i < 4; ++i) { const u32x4 ov = *(const LAS u32x4*)(PS + orow * 136 + ocol + 8 * i); u32x4 wv;
#pragma unroll
              for (int j = 0; j < 4; ++j) { const float g0 = bf_lo(go[i][j]), g1 = bf_hi(go[i][j]); wv[j] = pk2(bf_lo(ov[j]) * (g0 * sigm(g0)), bf_hi(ov[j]) * (g1 * sigm(g1))); }
              *(u32x4*)(yo + 8 * i) = wv; } }
        __syncthreads();
    }
}

__device__ __forceinline__ void p4_lru_fix(Ctx& F) {
    const bf16_t* proj = (const bf16_t*)(F.ws + WS_PROJ); bf16_t* Y = (bf16_t*)(F.ws + WS_Y);
    const bf16_t* hlocB = (const bf16_t*)F.out + (size_t)S_ * D_; const bf16_t* pcumB = hlocB + (size_t)S_ * DLRU;
    const float* carry = (const float*)(F.ws + WS_CARRY);
    for (int i = F.bid * NTHR + F.tid; i < S_ * (DLRU / 8); i += F.G * NTHR) {
        const int t = i >> 7, c = (i & 127) * 8;
        const u32x4 hl = *(const u32x4*)(hlocB + (size_t)t * DLRU + c), pc = *(const u32x4*)(pcumB + (size_t)t * DLRU + c), gw = *(const u32x4*)(proj + (size_t)t * DIN + DLRU + c);
        const float* cp = carry + (size_t)(t >> 6) * DLRU + c; const f32x4 c0 = *(const f32x4*)cp, c1 = *(const f32x4*)(cp + 4);
        u32x4 o;
#pragma unroll
        for (int q = 0; q < 4; ++q) { const float ca = q < 2 ? c0[2 * q] : c1[2 * q - 4], cb = q < 2 ? c0[2 * q + 1] : c1[2 * q - 3];
            const float ha = bf_lo(hl[q]) + bf_lo(pc[q]) * ca, hb = bf_hi(hl[q]) + bf_hi(pc[q]) * cb, ga = bf_lo(gw[q]), gb = bf_hi(gw[q]);
            const float ua = 0.7978845608028654f * (ga + 0.044715f * ga * ga * ga), ub = 0.7978845608028654f * (gb + 0.044715f * gb * gb * gb);
            o[q] = pk2(ha * ga * sigm(2.0f * ua), hb * gb * sigm(2.0f * ub)); }
        *(u32x4*)(Y + (size_t)t * D_ + c) = o;
    }
}

__device__ __forceinline__ void p8_final(Ctx& F) {
    const int gw = F.bid * NWAVES + F.wave, NGW = F.G * NWAVES;
    const float* ss3 = (const float*)(F.ws + WS_SS3);
    for (int m = gw; m < S_; m += NGW) {
        const f32x4 p0 = *(const f32x4*)(ss3 + (size_t)m * 8), p1 = *(const f32x4*)(ss3 + (size_t)m * 8 + 4);
        const float tot = ((p0[0] + p0[1]) + (p0[2] + p0[3])) + ((p1[0] + p1[1]) + (p1[2] + p1[3]));
        const float rstd = 1.0f / sqrtf(tot * (1.0f / D_) + EPS);
        f32x4* xr = (f32x4*)(F.out + (size_t)m * D_) + F.lane; const f32x4* wr = (const f32x4*)F.fnw + F.lane;
#pragma unroll
        for (int j = 0; j < 8; ++j) { const f32x4 v = xr[64 * j], wv = wr[64 * j]; xr[64 * j] = v * rstd * wv; }
    }
}

__global__ void __launch_bounds__(NTHR, 2) hymba_fwd(Args args) {
    extern __shared__ __attribute__((aligned(16))) unsigned char lds_raw[];
    Ctx F;
    F.lds = (LAS unsigned char*)lds_raw;
    F.tid = threadIdx.x; F.lane = F.tid & 63; F.wave = __builtin_amdgcn_readfirstlane(F.tid >> 6); F.G = gridDim.x; F.bid = blockIdx.x;
    F.x = args.in[0]; F.ln1 = args.in[1]; F.w_in = args.in[2]; F.conv_w = args.in[3]; F.conv_b = args.in[4]; F.ga_w = args.in[5]; F.ga_b = args.in[6]; F.gx_w = args.in[7];
    F.gx_b = args.in[8]; F.lam = args.in[9]; F.gn_w = args.in[10]; F.w_out = args.in[11]; F.ln2 = args.in[12]; F.w_g = args.in[13]; F.w_u = args.in[14]; F.w_d = args.in[15]; F.fnw = args.in[16];
    F.out = args.out; F.ws = args.ws;
    const int lo = args.ph_lo, hi = args.ph_hi;
#define IN(k) (lo <= (k) && (k) < hi)
#define SEAM(k) do { if (IN(k) && IN((k) + 1)) { xcd_barrier(bar); } } while (0)
    unsigned char* ws = args.ws;
    XcdBarrier bar; bar.bar = (unsigned*)(ws + WS_BAR); bar.x = 0; bar.st = (volatile LAS unsigned*)(F.lds + LDS_CTL);
    if (hi - lo > 1) {
        if (F.tid < 4) ((LAS unsigned*)(F.lds + LDS_CTL))[F.tid] = 0u;
        __syncthreads();
        bar = xcd_barrier_post((unsigned*)(ws + WS_BAR), (volatile LAS unsigned*)(F.lds + LDS_CTL));
    }
    if (lo == 12345) cg::this_grid().sync();

    if (IN(0)) { p0_prologue(F, 0, F.bid * NWAVES + F.wave, F.G * NWAVES); }
    SEAM(0);
    if (IN(1)) {
        pg8::Gemm g{(const bf16_t*)F.out, (const bf16_t*)(ws + WS_WIN), S_, DIN, D_}; pg8::StaticOrder S; S.init(S_, DIN, F.G, F.bid);
        pg8::EpiProj E{(bf16_t*)(ws + WS_PROJ), DIN, (const float*)(ws + WS_RSTD1)};
        pg8::gemm_phase<pg8::EpiProj, pg8::StaticOrder, true, true>(F.lds, g, S, E);
        if (REP_MASK & 2) pg8::gemm_phase<pg8::EpiProj, pg8::StaticOrder, true, true>(F.lds, g, S, E);
    }
    SEAM(1);
    if (IN(2)) { p2_lru<false>(F, 1, F.bid * NWAVES + F.wave, F.G * NWAVES, 4);   p2_ret(F); }
    SEAM(2);
    u32x4 pq[4], pk[4], pv[4], pg[4];
    if (IN(3)) { p4_ret_preload(F, pq, pk, pv, pg); p3_carries(F); }
    SEAM(3);
    if (IN(4)) { if (!IN(3)) p4_ret_preload(F, pq, pk, pv, pg); p4_ret(F, pq, pk, pv, pg);
        p4_lru_fix(F);
        p0_prologue(F, 1, (F.bid + 4 * F.G) * NWAVES + F.wave, F.G * NWAVES); }
    SEAM(4);
    if (IN(5)) {
        pg8::Gemm g{(const bf16_t*)(ws + WS_Y), (const bf16_t*)(ws + WS_WOUT), S_, D_, D_}; pg8::StaticOrder S; S.init(S_, D_, F.G, F.bid);
        pg8::EpiResid E{(const bf16_t*)F.out, nullptr, (bf16_t*)(ws + WS_H1B), D_, (float*)(ws + WS_SS2)};
        pg8::gemm_phase<pg8::EpiResid, pg8::StaticOrder, false, true>(F.lds, g, S, E);
        if (REP_MASK & 32) pg8::gemm_phase<pg8::EpiResid, pg8::StaticOrder, false, true>(F.lds, g, S, E);
    }
    SEAM(5);
    if (IN(6)) {
        pg8::Gemm g{(const bf16_t*)(ws + WS_H1B), (const bf16_t*)(ws + WS_WGU), S_, NGU, D_}; pg8::StaticOrder S; S.init(S_, NGU, F.G, F.bid);
        pg8::EpiSwiglu E{(bf16_t*)(ws + WS_FF), DFF, (const float*)(ws + WS_SS2)};
        pg8::gemm_phase<pg8::EpiSwiglu, pg8::StaticOrder, true, true>(F.lds, g, S, E);
        if (REP_MASK & 64) pg8::gemm_phase<pg8::EpiSwiglu, pg8::StaticOrder, true, true>(F.lds, g, S, E);
        const int nun = (S_ / 256) * (NGU / 256), full = nun / F.G, rem = nun % F.G;
        if (rem == 0) p0_prologue(F, 2, F.bid * NWAVES + F.wave, F.G * NWAVES);
        else if (F.bid >= rem) p0_prologue(F, 2, (F.bid - rem) * NWAVES + F.wave, (F.G - rem) * NWAVES);
        (void)full;
    }
    SEAM(6);
    if (IN(7)) {
        pg8::Gemm g{(const bf16_t*)(ws + WS_FF), (const bf16_t*)(ws + WS_WD), S_, D_, DFF}; pg8::StaticOrder S; S.init(S_, D_, F.G, F.bid);
        if (REP_MASK & 128) { pg8::EpiNull E{(float*)(ws + WS_SS2)}; pg8::gemm_phase<pg8::EpiNull, pg8::StaticOrder, false, true>(F.lds, g, S, E); }
        if (hi - lo > 1) {
            pg8::EpiFinal E{(const bf16_t*)(ws + WS_H1B), F.out, D_, (float*)(ws + WS_SS3), (unsigned*)(ws + WS_PCNT), F.fnw, (unsigned*)(ws + WS_PCNT + 32 * 256)};
            pg8::gemm_phase<pg8::EpiFinal, pg8::StaticOrder, false, true>(F.lds, g, S, E);
        } else {
            pg8::EpiResid E{(const bf16_t*)(ws + WS_H1B), F.out, nullptr, D_, (float*)(ws + WS_SS3)};
            pg8::gemm_phase<pg8::EpiResid, pg8::StaticOrder, false, true>(F.lds, g, S, E);
        }
    }
    if (hi - lo <= 1) { if (IN(8)) { p8_final(F); } }
#undef IN
#undef SEAM
}

extern "C" void kernel_launch(void* const* d_in, const int* in_sizes, int n_in, void* d_out, int out_size, void* d_ws, size_t ws_size, hipStream_t stream) {
    static int grid = 0;
    if (grid == 0) {
        if (n_in != 17 || out_size != S_ * D_ || ws_size < WS_END) { fprintf(stderr, "kernel_launch: unexpected shapes: n_in %d out %d ws %zu (need %zu)\n", n_in, out_size, ws_size, (size_t)WS_END); grid = -1; return; }
        int dev = 0, cus = 0, per_cu = 0;
        (void)hipGetDevice(&dev); (void)hipDeviceGetAttribute(&cus, hipDeviceAttributeMultiprocessorCount, dev);
        if (hipFuncSetAttribute((const void*)hymba_fwd, hipFuncAttributeMaxDynamicSharedMemorySize, LDS_BYTES) != hipSuccess) { fprintf(stderr, "kernel_launch: hipFuncSetAttribute failed\n"); grid = -1; return; }
        (void)hipOccupancyMaxActiveBlocksPerMultiprocessor(&per_cu, (const void*)hymba_fwd, NTHR, LDS_BYTES);
        (void)hipGetLastError();
        if (per_cu < 1) { fprintf(stderr, "kernel_launch: occupancy query says %d blocks per CU\n", per_cu); per_cu = 1; }
        grid = cus;
        if (grid != 256) fprintf(stderr, "kernel_launch: grid %d != 256: the residual GEMM phases need one unit per workgroup\n", grid);
    }
    if (grid < 0) return;
    Args a{};
    for (int i = 0; i < 17; ++i) a.in[i] = (const float*)d_in[i];
    a.out = (float*)d_out; a.ws = (unsigned char*)d_ws;
#if MK_ONE_LAUNCH
    if (hipMemsetAsync((char*)d_ws + WS_BAR, 0, CTL_ZERO_BYTES, stream) != hipSuccess) { fprintf(stderr, "kernel_launch: memset of barrier words failed\n"); return; }
    a.ph_lo = 0; a.ph_hi = 9;
    void* kargs[] = {&a};
    hipError_t e = hipLaunchCooperativeKernel((const void*)hymba_fwd, dim3(grid), dim3(NTHR), kargs, LDS_BYTES, stream);
    if (e != hipSuccess) fprintf(stderr, "kernel_launch: cooperative launch failed: %s (grid %d)\n", hipGetErrorString(e), grid);
#else
    for (int p = 0; p < 9; ++p) { a.ph_lo = p; a.ph_hi = p + 1; hipLaunchKernelGGL(hymba_fwd, dim3(grid), dim3(NTHR), LDS_BYTES, stream, a); }
#endif
}
```

```cpp
#include <hip/hip_runtime.h>
#include <hip/hip_cooperative_groups.h>
#include <cstdio>
#include <cstdint>
namespace cg = cooperative_groups;

#ifndef REP_MASK
#define REP_MASK 0
#endif
#ifndef MK_ONE_LAUNCH
#define MK_ONE_LAUNCH 1
#endif

#define LAS __attribute__((address_space(3)))
typedef unsigned short bf16_t;
typedef short bf16x8 __attribute__((ext_vector_type(8)));
typedef float f32x4 __attribute__((ext_vector_type(4)));
typedef float f32x2 __attribute__((ext_vector_type(2)));
typedef unsigned u32x4 __attribute__((ext_vector_type(4)));
typedef unsigned u32x2 __attribute__((ext_vector_type(2)));

constexpr int S_ = 8192, D_ = 2048, DIN = 6144, DLRU = 1024, DRET = 1024, DFF = 5632, NGU = 2 * DFF;
constexpr int NWAVES = 8, NTHR = 512;
constexpr float EPS = 1e-6f;
constexpr int LCH = 64;
constexpr int NLCH = S_ / LCH;
constexpr int RCH = 128, NRCH = S_ / RCH;
constexpr size_t MiB = 1u << 20;
constexpr size_t WS_RSTD1 = 0, WS_SS2 = 64 * 1024, WS_SS3 = 320 * 1024, WS_GAT = 576 * 1024, WS_GXT = 832 * 1024,
                 WS_ATOT = 1088 * 1024, WS_HEND = 1600 * 1024, WS_CARRY = 2112 * 1024;
constexpr size_t WS_ROPEC = 4 * MiB, WS_ROPES = 6 * MiB;
constexpr size_t WS_WOUT = 8 * MiB, WS_WGU = 16 * MiB, WS_WD = 60 * MiB, WS_PROJ = 82 * MiB;
constexpr size_t WS_WIN = 178 * MiB, WS_XB = 202 * MiB;
constexpr size_t WS_KV = 178 * MiB, WS_RP = 210 * MiB;
constexpr size_t WS_Y = 226 * MiB;
constexpr size_t WS_H1B = 82 * MiB, WS_FF = 114 * MiB;
constexpr size_t WS_END = 258 * MiB;
constexpr size_t WS_BAR = 2688 * 1024;
constexpr size_t WS_PCNT = WS_BAR + 16 * 1024;
constexpr size_t CTL_ZERO_BYTES = 16 * 1024 + 32 * 256 + 256;
constexpr int LDS_CTL = 163840 - 256;
constexpr int LDS_BYTES = 163840;

__device__ __forceinline__ unsigned pk2(float lo, float hi) { unsigned r; asm volatile("v_cvt_pk_bf16_f32 %0, %1, %2" : "=v"(r) : "v"(lo), "v"(hi)); return r; }
__device__ __forceinline__ unsigned pk2_sw(float lo, float hi) { unsigned a = __float_as_uint(lo), b = __float_as_uint(hi); a += 0x7fffu + ((a >> 16) & 1u); b += 0x7fffu + ((b >> 16) & 1u); return (a >> 16) | (b & 0xffff0000u); }
__device__ __forceinline__ float bf_lo(unsigned w) { return __uint_as_float(w << 16); }
__device__ __forceinline__ float bf_hi(unsigned w) { return __uint_as_float(w & 0xffff0000u); }
__device__ __forceinline__ float sigm(float z) { return __builtin_amdgcn_rcpf(1.f + __builtin_amdgcn_exp2f(-1.4426950408889634f * z)); }
__device__ __forceinline__ float wave_sum(float v) {
#pragma unroll
    for (int o = 1; o < 64; o <<= 1) v += __shfl_xor(v, o);
    return v;
}

namespace pg8 {
constexpr int BM = 256, BK = 64, HALF = 128, HTB = HALF * BK * 2, STAGE_BYTES = 8 * HTB, NXCD = 8, WGM = 8;
__host__ __device__ __forceinline__ int lds_byte(int r, int c) { const int st = (r >> 4) * 2 + (c >> 5), rr = r & 15, cc = c & 31, ob = rr * 64 + cc * 2; return st * 1024 + (ob ^ (((ob >> 9) & 1) << 5)); }
__host__ __device__ __forceinline__ void stage_rc(int b, int& R, int& C) { const int st = b / 1024, sb = b % 1024, swz = sb ^ (((sb >> 9) & 1) << 5); R = (st >> 1) * 16 + swz / 64; C = (st & 1) * 32 + (swz % 64) / 2; }
__host__ __device__ __forceinline__ int perm32(int rho) { const int n = rho >> 4, i = rho & 15; return 8 * (i >> 2) + 4 * n + (i & 3); }
struct Unit { int pm, pn; };
struct Gemm { const bf16_t* A; const bf16_t* Bt; int M, N, K; };
struct StaticOrder {
    int nM, nN, nwg, G, c;
    __host__ __device__ void init(int M, int N, int G_, int c_) { nM = M / BM; nN = N / BM; nwg = nM * nN; G = G_; c = c_; }
    __host__ __device__ bool next(int i, Unit& u) const {
        const long L = (long)i * G + c; if (L >= nwg) return false;
        int wgid = (int)L; { const int q = nwg / NXCD, r = nwg % NXCD, xcd = wgid % NXCD, off = wgid / NXCD; wgid = (xcd < r ? xcd * (q + 1) : r * (q + 1) + (xcd - r) * q) + off; }
        const int nig = WGM * nN, gid = wgid / nig, fm = gid * WGM, gsz = (nM - fm) < WGM ? (nM - fm) : WGM;
        u.pm = fm + ((wgid % nig) % gsz); u.pn = (wgid % nig) / gsz; return true;
    }
};

struct EpiProj {
    static constexpr bool PERM = true, AFTER_DRAIN = false;
    bf16_t* O; int ldc; const float* rs;
    __device__ __forceinline__ void operator()(const f32x4 (&acc)[2][2][4][2], const Unit& u, int wr, int wc, int fr, int fq) const {
        const int row0 = u.pm * BM + wr * 64 + fr, col0 = u.pn * BM + wc * 32 + 8 * fq;
#pragma unroll
        for (int ai = 0; ai < 2; ++ai)
#pragma unroll
            for (int m = 0; m < 4; ++m) { const int r = row0 + ai * HALF + m * 16; const float s = rs[r]; bf16_t* rowp = O + (size_t)r * ldc + col0;
#pragma unroll
                for (int bj = 0; bj < 2; ++bj) { const f32x4 v0 = acc[ai][bj][m][0] * s, v1 = acc[ai][bj][m][1] * s;
                    u32x4 w; w.x = pk2(v0[0], v0[1]); w.y = pk2(v0[2], v0[3]); w.z = pk2(v1[0], v1[1]); w.w = pk2(v1[2], v1[3]);
                    *(u32x4*)(rowp + bj * HALF) = w; } }
    }
};
struct EpiSwiglu {
    static constexpr bool PERM = true, AFTER_DRAIN = false;
    bf16_t* O; int ldc; const float* ss;
    __device__ __forceinline__ void operator()(const f32x4 (&acc)[2][2][4][2], const Unit& u, int wr, int wc, int fr, int fq) const {
        const int row0 = u.pm * BM + wr * 64 + fr, col0 = u.pn * HALF + wc * 32 + 8 * fq;
#pragma unroll
        for (int ai = 0; ai < 2; ++ai)
#pragma unroll
            for (int m = 0; m < 4; ++m) { const int r = row0 + ai * HALF + m * 16;
                const f32x4 p0 = *(const f32x4*)(ss + (size_t)r * 8), p1 = *(const f32x4*)(ss + (size_t)r * 8 + 4);
                const float tot = ((p0[0] + p0[1]) + (p0[2] + p0[3])) + ((p1[0] + p1[1]) + (p1[2] + p1[3]));
                const float s = __builtin_amdgcn_rsqf(tot * (1.0f / D_) + EPS);
                float o[8];
#pragma unroll
                for (int n = 0; n < 2; ++n)
#pragma unroll
                    for (int j = 0; j < 4; ++j) { const float g = acc[ai][0][m][n][j] * s, up = acc[ai][1][m][n][j] * s; o[n * 4 + j] = g * sigm(g) * up; }
                u32x4 w; w.x = pk2(o[0], o[1]); w.y = pk2(o[2], o[3]); w.z = pk2(o[4], o[5]); w.w = pk2(o[6], o[7]);
                *(u32x4*)(O + (size_t)r * ldc + col0) = w; }
    }
};
struct EpiNull { static constexpr bool PERM = true, AFTER_DRAIN = false; float* sink;
    __device__ __forceinline__ void operator()(const f32x4 (&acc)[2][2][4][2], const Unit& u, int wr, int wc, int fr, int fq) const { if (acc[0][0][0][0][0] == 123.456f) sink[0] = 1.f; } };
struct EpiResid {
    static constexpr bool PERM = true, AFTER_DRAIN = true;
    const bf16_t* base; float* out; bf16_t* ob; int ldc; float* ss;
    __device__ __forceinline__ void fused(f32x4 (&acc)[2][2][4][2], const Unit& u, int wr, int wc, int fr, int fq, LAS unsigned char* lds, int wid, int lane) const {
        LAS float* P = (LAS float*)lds;
        const int col0 = u.pn * BM + wc * 32 + 8 * fq;
#pragma unroll
        for (int ai = 0; ai < 2; ++ai)
#pragma unroll
            for (int m = 0; m < 4; ++m) { const int rl = ai * HALF + wr * 64 + m * 16 + fr; const size_t off = (size_t)(u.pm * BM + rl) * ldc + col0; float q = 0.f;
#pragma unroll
                for (int bj = 0; bj < 2; ++bj) {
                    const u32x4 bw = *(const u32x4*)(base + off + bj * HALF);
                    const f32x4 b0 = (f32x4){bf_lo(bw.x), bf_hi(bw.x), bf_lo(bw.y), bf_hi(bw.y)}, b1 = (f32x4){bf_lo(bw.z), bf_hi(bw.z), bf_lo(bw.w), bf_hi(bw.w)};
                    const f32x4 v0 = acc[ai][bj][m][0] + b0, v1 = acc[ai][bj][m][1] + b1;
                    if (out) { *(f32x4*)(out + off + bj * HALF) = v0; *(f32x4*)(out + off + bj * HALF + 4) = v1; }
                    if (ob) { u32x4 w; w.x = pk2(v0[0], v0[1]); w.y = pk2(v0[2], v0[3]); w.z = pk2(v1[0], v1[1]); w.w = pk2(v1[2], v1[3]); *(u32x4*)(ob + off + bj * HALF) = w; }
                    q += (v0[0] * v0[0] + v0[1] * v0[1]) + (v0[2] * v0[2] + v0[3] * v0[3]) + (v1[0] * v1[0] + v1[1] * v1[1]) + (v1[2] * v1[2] + v1[3] * v1[3]); }
                q += __shfl_xor(q, 16); q += __shfl_xor(q, 32);
                if (fq == 0) P[rl * 4 + wc] = q;
                if (m & 1) asm volatile("" ::: "memory"); }
        __syncthreads();
        const int t = wid * 64 + lane;
        if (t < 256) { const f32x4 p = *(const LAS f32x4*)(P + t * 4); ss[(size_t)(u.pm * BM + t) * 8 + u.pn] = (p[0] + p[1]) + (p[2] + p[3]); }
        __syncthreads();
    }
};

struct EpiFinal {
    static constexpr bool PERM = true, AFTER_DRAIN = true;
    const bf16_t* base; float* out; int ldc; float* ss; unsigned* cnt; const float* w; unsigned* tmo;
    __device__ __forceinline__ void fused(f32x4 (&acc)[2][2][4][2], const Unit& u, int wr, int wc, int fr, int fq, LAS unsigned char* lds, int wid, int lane) const {
        LAS float* P = (LAS float*)lds;
        LAS float* R = (LAS float*)(lds + 4096);
        const int col0 = u.pn * BM + wc * 32 + 8 * fq;
#pragma unroll
        for (int ai = 0; ai < 2; ++ai)
#pragma unroll
            for (int m = 0; m < 4; ++m) { const int rl = ai * HALF + wr * 64 + m * 16 + fr; const size_t off = (size_t)(u.pm * BM + rl) * ldc + col0; float q = 0.f;
#pragma unroll
                for (int bj = 0; bj < 2; ++bj) {
                    const u32x4 bw = *(const u32x4*)(base + off + bj * HALF);
                    const f32x4 b0 = (f32x4){bf_lo(bw.x), bf_hi(bw.x), bf_lo(bw.y), bf_hi(bw.y)}, b1 = (f32x4){bf_lo(bw.z), bf_hi(bw.z), bf_lo(bw.w), bf_hi(bw.w)};
                    const f32x4 v0 = acc[ai][bj][m][0] + b0, v1 = acc[ai][bj][m][1] + b1;
                    acc[ai][bj][m][0] = v0; acc[ai][bj][m][1] = v1;
                    q += (v0[0] * v0[0] + v0[1] * v0[1]) + (v0[2] * v0[2] + v0[3] * v0[3]) + (v1[0] * v1[0] + v1[1] * v1[1]) + (v1[2] * v1[2] + v1[3] * v1[3]); }
                q += __shfl_xor(q, 16); q += __shfl_xor(q, 32);
                if (fq == 0) P[rl * 4 + wc] = q;
                if (m & 1) asm volatile("" ::: "memory"); }
        __syncthreads();
        const int t = wid * 64 + lane;
        unsigned* pc = cnt + 64 * u.pm;
        if (t < 256) { const f32x4 p = *(const LAS f32x4*)(P + t * 4);
            __hip_atomic_store(ss + (size_t)(u.pm * BM + t) * 8 + u.pn, (p[0] + p[1]) + (p[2] + p[3]), __ATOMIC_RELAXED, __HIP_MEMORY_SCOPE_AGENT);
            asm volatile("s_waitcnt vmcnt(0)" ::: "memory");
            if (lane == 0) __hip_atomic_fetch_add(pc, 1u, __ATOMIC_RELAXED, __HIP_MEMORY_SCOPE_AGENT); }
        if (wid == 0) {
            unsigned sp = 0;
            while ((unsigned)__builtin_amdgcn_readfirstlane(__hip_atomic_load(pc, __ATOMIC_RELAXED, __HIP_MEMORY_SCOPE_AGENT)) < 32u) {
                __builtin_amdgcn_s_sleep(2);
                if (++sp > (1u << 22)) { if (lane == 0) __hip_atomic_store(tmo, 1u, __ATOMIC_RELAXED, __HIP_MEMORY_SCOPE_AGENT); break; } }
            __builtin_amdgcn_fence(__ATOMIC_ACQUIRE, "agent");
            asm volatile("s_waitcnt vmcnt(0)" ::: "memory");
        }
        __syncthreads();
        if (t < 256) { const float* sp8 = ss + (size_t)(u.pm * BM + t) * 8; float tot = 0.f;
#pragma unroll
            for (int j = 0; j < 8; ++j) tot += __hip_atomic_load(sp8 + j, __ATOMIC_RELAXED, __HIP_MEMORY_SCOPE_AGENT);
            R[t] = 1.0f / sqrtf(tot * (1.0f / D_) + EPS); }
        __syncthreads();
        f32x4 wv[2][2];
#pragma unroll
        for (int bj = 0; bj < 2; ++bj) { wv[bj][0] = *(const f32x4*)(w + col0 + bj * HALF); wv[bj][1] = *(const f32x4*)(w + col0 + bj * HALF + 4); }
#pragma unroll
        for (int ai = 0; ai < 2; ++ai)
#pragma unroll
            for (int m = 0; m < 4; ++m) { const int rl = ai * HALF + wr * 64 + m * 16 + fr; const size_t off = (size_t)(u.pm * BM + rl) * ldc + col0; const float rs = R[rl];
#pragma unroll
                for (int bj = 0; bj < 2; ++bj) { *(f32x4*)(out + off + bj * HALF) = acc[ai][bj][m][0] * rs * wv[bj][0]; *(f32x4*)(out + off + bj * HALF + 4) = acc[ai][bj][m][1] * rs * wv[bj][1]; } }
        __syncthreads();
    }
};

template <class Epi, class Sched, bool ALIGN_EPI = false, bool SP2 = false>
__device__ __forceinline__ void gemm_phase(LAS unsigned char* lds, const Gemm g, const Sched& S, const Epi& E) {
    const int tid = threadIdx.x, wid = __builtin_amdgcn_readfirstlane(tid >> 6), lane = tid & 63, wr = wid >> 2, wc = wid & 3, fr = lane & 15, fq = lane >> 4;
    const int K = g.K, nt = K / BK;
    unsigned voffA[2], voffB[2];
#pragma unroll
    for (int i = 0; i < 2; ++i) { int R, C; stage_rc(tid * 16 + i * 8192, R, C); const int Rb = Epi::PERM ? ((R & ~31) + perm32(R & 31)) : R;
        voffA[i] = (unsigned)(R * K + C) * 2u; voffB[i] = (unsigned)(Rb * K + C) * 2u; }
    const size_t kstep = (size_t)(BK * 2);
    const size_t hstep = (size_t)HALF * K * 2;
    const size_t tstep = 2 * hstep;
    const unsigned ldsw = (unsigned)wid * 1024u;
    const int aoff = lds_byte(wr * 64 + fr, fq * 8), boff = lds_byte(wc * 32 + fr, fq * 8);
#define PG8_SA(b, h) (((b) * 2 + (h)) * HTB)
#define PG8_SB(b, h) ((4 + (b) * 2 + (h)) * HTB)
#define PG8_STAGE(bufoff, gbase, voff) do { _Pragma("unroll") for (int _i = 0; _i < 2; ++_i) \
        __builtin_amdgcn_global_load_lds((const unsigned*)((const char*)(gbase) + (voff)[_i]), (LAS unsigned*)(lds + (bufoff) + ldsw + _i * 8192), 16, 0, 0); } while (0)
#define PG8_LDA(dst, b, h) do { _Pragma("unroll") for (int m = 0; m < 4; ++m) _Pragma("unroll") for (int k = 0; k < 2; ++k) dst[m][k] = *(const LAS bf16x8*)(lds + PG8_SA(b, h) + aoff + m * 2048 + k * 1024); } while (0)
#define PG8_LDB(dst, b, h) do { _Pragma("unroll") for (int n = 0; n < 2; ++n) _Pragma("unroll") for (int k = 0; k < 2; ++k) dst[n][k] = *(const LAS bf16x8*)(lds + PG8_SB(b, h) + boff + n * 2048 + k * 1024); } while (0)
#define PG8_MMA(ai, bj, At, Bt) do { __builtin_amdgcn_s_setprio(1); _Pragma("unroll") for (int m = 0; m < 4; ++m) _Pragma("unroll") for (int n = 0; n < 2; ++n) _Pragma("unroll") for (int k = 0; k < 2; ++k) \
        acc[ai][bj][m][n] = __builtin_amdgcn_mfma_f32_16x16x32_bf16(Bt[n][k], At[m][k], acc[ai][bj][m][n], 0, 0, 0); __builtin_amdgcn_s_setprio(0); } while (0)
#define PG8_WAIT_V(n) asm volatile("s_waitcnt vmcnt(" #n ")" ::: "memory")
#define PG8_WAIT_L(n) asm volatile("s_waitcnt lgkmcnt(" #n ")" ::: "memory")
#define PG8_BAR __builtin_amdgcn_s_barrier()
#define PG8_SCHED __builtin_amdgcn_sched_barrier(0)
    Unit cur, nxt; int ui = 0;
    if (!S.next(0, cur)) return;
    f32x4 acc[2][2][4][2];
#pragma unroll
    for (int a = 0; a < 2; ++a)
#pragma unroll
        for (int b = 0; b < 2; ++b)
#pragma unroll
            for (int m = 0; m < 4; ++m)
#pragma unroll
                for (int n = 0; n < 2; ++n) acc[a][b][m][n] = (f32x4){0.f, 0.f, 0.f, 0.f};
    bf16x8 At[4][2], B0[2][2], B1[2][2];
    const char* cA = (const char*)g.A + (size_t)cur.pm * tstep; const char* cB = (const char*)g.Bt + (size_t)cur.pn * tstep;
    if constexpr (SP2) {
        PG8_STAGE(PG8_SB(0, 0), cB, voffB); PG8_STAGE(PG8_SB(0, 1), cB + hstep, voffB); PG8_STAGE(PG8_SA(0, 0), cA, voffA); PG8_STAGE(PG8_SA(0, 1), cA + hstep, voffA);
        if (wr == 1) PG8_BAR;
        PG8_WAIT_V(2); PG8_BAR;
        PG8_STAGE(PG8_SB(1, 0), cB + kstep, voffB); PG8_STAGE(PG8_SA(1, 0), cA + kstep, voffA); PG8_STAGE(PG8_SB(1, 1), cB + hstep + kstep, voffB);
        PG8_WAIT_V(6); PG8_BAR;
    } else {
        PG8_STAGE(PG8_SB(0, 0), cB, voffB); PG8_STAGE(PG8_SA(0, 0), cA, voffA); PG8_STAGE(PG8_SB(0, 1), cB + hstep, voffB); PG8_STAGE(PG8_SA(0, 1), cA + hstep, voffA);
        if (wr == 1) PG8_BAR;
        PG8_WAIT_V(4); PG8_BAR;
        PG8_STAGE(PG8_SB(1, 0), cB + kstep, voffB); PG8_STAGE(PG8_SA(1, 0), cA + kstep, voffA); PG8_STAGE(PG8_SB(1, 1), cB + hstep + kstep, voffB);
        PG8_WAIT_V(6); PG8_BAR;
    }
    for (;;) {
        const bool has_next = S.next(ui + 1, nxt);
        const char* nA = has_next ? (const char*)g.A + (size_t)nxt.pm * tstep : cA; const char* nB = has_next ? (const char*)g.Bt + (size_t)nxt.pn * tstep : cB;
        for (int t = 0; t < nt; t += 2) {
            const bool last = (t == nt - 2);
            const char* a1 = cA + (size_t)(t + 1) * kstep;
            const char* a2 = last ? nA : cA + (size_t)(t + 2) * kstep; const char* b2 = last ? nB : cB + (size_t)(t + 2) * kstep;
            const char* a3 = a2 + kstep; const char* b3 = b2 + kstep;
            if constexpr (SP2) {
            PG8_LDB(B0, 0, 0); PG8_LDB(B1, 0, 1); PG8_SCHED; PG8_LDA(At, 0, 0); PG8_STAGE(PG8_SA(1, 1), a1 + hstep, voffA);
            PG8_WAIT_V(8); PG8_WAIT_L(0); PG8_BAR; PG8_MMA(0, 0, At, B0); PG8_MMA(0, 1, At, B1); PG8_BAR; PG8_SCHED;
            PG8_LDA(At, 0, 1); PG8_STAGE(PG8_SB(0, 0), b2, voffB); PG8_STAGE(PG8_SB(0, 1), b2 + hstep, voffB); PG8_STAGE(PG8_SA(0, 0), a2, voffA);
            PG8_WAIT_V(8); PG8_WAIT_L(0); PG8_BAR; PG8_MMA(1, 0, At, B0); PG8_MMA(1, 1, At, B1); PG8_BAR; PG8_SCHED;
            PG8_LDB(B0, 1, 0); PG8_LDB(B1, 1, 1); PG8_SCHED; PG8_LDA(At, 1, 0); PG8_STAGE(PG8_SA(0, 1), a2 + hstep, voffA);
            PG8_WAIT_V(8); PG8_WAIT_L(0); PG8_BAR; PG8_MMA(0, 0, At, B0); PG8_MMA(0, 1, At, B1); PG8_BAR; PG8_SCHED;
            PG8_LDA(At, 1, 1); PG8_STAGE(PG8_SB(1, 0), b3, voffB); PG8_STAGE(PG8_SB(1, 1), b3 + hstep, voffB); PG8_STAGE(PG8_SA(1, 0), a3, voffA);
            PG8_WAIT_V(8); PG8_WAIT_L(0); PG8_BAR; PG8_MMA(1, 0, At, B0); PG8_MMA(1, 1, At, B1); PG8_BAR; PG8_SCHED;
            } else {
            PG8_LDB(B0, 0, 0); PG8_SCHED; PG8_LDA(At, 0, 0); PG8_STAGE(PG8_SA(1, 1), a1 + hstep, voffA);
            PG8_WAIT_L(8); PG8_BAR; PG8_WAIT_L(0); PG8_MMA(0, 0, At, B0); PG8_BAR; PG8_SCHED;
            PG8_LDB(B1, 0, 1); PG8_STAGE(PG8_SB(0, 0), b2, voffB);
            PG8_BAR; PG8_WAIT_L(0); PG8_MMA(0, 1, At, B1); PG8_BAR;
            PG8_LDA(At, 0, 1); PG8_STAGE(PG8_SA(0, 0), a2, voffA);
            PG8_BAR; PG8_WAIT_L(0); PG8_MMA(1, 0, At, B0); PG8_BAR; PG8_SCHED;
            PG8_STAGE(PG8_SB(0, 1), b2 + hstep, voffB);
            PG8_WAIT_V(6); PG8_BAR; PG8_MMA(1, 1, At, B1); PG8_BAR;
            PG8_LDB(B0, 1, 0); PG8_SCHED; PG8_LDA(At, 1, 0); PG8_STAGE(PG8_SA(0, 1), a2 + hstep, voffA);
            PG8_WAIT_L(8); PG8_BAR; PG8_WAIT_L(0); PG8_MMA(0, 0, At, B0); PG8_BAR; PG8_SCHED;
            PG8_LDB(B1, 1, 1); PG8_STAGE(PG8_SB(1, 0), b3, voffB);
            PG8_BAR; PG8_WAIT_L(0); PG8_MMA(0, 1, At, B1); PG8_BAR;
            PG8_LDA(At, 1, 1); PG8_STAGE(PG8_SA(1, 0), a3, voffA);
            PG8_BAR; PG8_WAIT_L(0); PG8_MMA(1, 0, At, B0); PG8_BAR; PG8_SCHED;
            PG8_STAGE(PG8_SB(1, 1), b3 + hstep, voffB);
            PG8_WAIT_V(6); PG8_BAR; PG8_MMA(1, 1, At, B1); PG8_BAR;
            }
        }
        if constexpr (ALIGN_EPI) { if (wr == 0) PG8_BAR; }
        if constexpr (!Epi::AFTER_DRAIN) { E(acc, cur, wr, wc, fr, fq); }
        if (!has_next) break;
#pragma unroll
        for (int a = 0; a < 2; ++a)
#pragma unroll
            for (int b = 0; b < 2; ++b)
#pragma unroll
                for (int m = 0; m < 4; ++m)
#pragma unroll
                    for (int n = 0; n < 2; ++n) acc[a][b][m][n] = (f32x4){0.f, 0.f, 0.f, 0.f};
        cur = nxt; cA = nA; cB = nB; ++ui;
        if constexpr (ALIGN_EPI) { if (wr == 1) PG8_BAR; }
    }
    PG8_WAIT_V(0);
    if constexpr (!ALIGN_EPI) { if (wr == 0) PG8_BAR; }
    PG8_BAR;
    if constexpr (Epi::AFTER_DRAIN) { E.fused(acc, cur, wr, wc, fr, fq, lds, wid, lane); }
#undef PG8_SA
#undef PG8_SB
#undef PG8_STAGE
#undef PG8_LDA
#undef PG8_LDB
#undef PG8_MMA
#undef PG8_WAIT_V
#undef PG8_WAIT_L
#undef PG8_BAR
#undef PG8_SCHED
}
}


#define XB_TMO      128
#define XB_XCNT(j)  (256  + 64 * (j))
#define XB_XSUB(j)  (1280 + 64 * (j))
#define XB_XGEN(j)  (2304 + 64 * (j))
#define XB_TOP      3328
#define XB_TOPGEN   3392
#define XCD_BAR_WORDS 3456
#define XB_SPIN_CAP (1u << 22)
__device__ __forceinline__ unsigned xb_ld(unsigned* p)              { return __hip_atomic_load(p, __ATOMIC_RELAXED, __HIP_MEMORY_SCOPE_AGENT); }
__device__ __forceinline__ unsigned xb_add(unsigned* p, unsigned v) { return __hip_atomic_fetch_add(p, v, __ATOMIC_RELAXED, __HIP_MEMORY_SCOPE_AGENT); }
__device__ __forceinline__ unsigned xb_xcc_id() { return (unsigned)__builtin_amdgcn_s_getreg((3 << 11) | 20) & 0xFu; }
#define XB_SPIN(cond, bar) do { unsigned _sp = 0; while (cond) { __builtin_amdgcn_s_sleep(1); \
    if ((++_sp & 255u) == 0u) { if (xb_ld(&(bar)[XB_TMO])) break; if (_sp > XB_SPIN_CAP) { atomicAdd(&(bar)[XB_TMO], 1u); break; } } } } while (0)
struct XcdBarrier { unsigned* bar; unsigned x; volatile LAS unsigned* st; };
__device__ __forceinline__ XcdBarrier xcd_barrier_post(unsigned* bar, volatile LAS unsigned* st) {
    XcdBarrier b; b.bar = bar; b.x = xb_xcc_id(); b.st = st;
    if (threadIdx.x == 0) (void)xb_add(&bar[XB_XCNT(b.x)], 1u);
    return b;
}
__device__ __forceinline__ void xcd_barrier_complete(unsigned* bar, unsigned x, unsigned& nloc, unsigned& nx) {
    const unsigned G = gridDim.x * gridDim.y * gridDim.z;
    unsigned sum, cnt, mine, sp = 0u;
    for (;;) {
        sum = 0u; cnt = 0u; mine = 0u;
#pragma unroll
        for (unsigned j = 0; j < 16; ++j) { const unsigned c = xb_ld(&bar[XB_XCNT(j)]); sum += c; cnt += (c > 0u) ? 1u : 0u; mine = (j == x) ? c : mine; }
        if (sum == G) break;
        __builtin_amdgcn_s_sleep(1);
        if ((++sp & 255u) == 0u) { if (xb_ld(&bar[XB_TMO])) break; if (sp > XB_SPIN_CAP) { atomicAdd(&bar[XB_TMO], 1u); break; } }
    }
    nloc = mine > 0u ? mine : 1u; nx = cnt > 0u ? cnt : 1u;
}
__device__ __forceinline__ void xcd_barrier(const XcdBarrier& b) {
    asm volatile("s_waitcnt vmcnt(0)" ::: "memory");
    __syncthreads();
    if (threadIdx.x == 0) {
        unsigned* bar = b.bar;
        __builtin_amdgcn_s_waitcnt(0);
        unsigned nloc = b.st[0], nx = b.st[1];
        if (nloc == 0u) { xcd_barrier_complete(bar, b.x, nloc, nx); b.st[0] = nloc; b.st[1] = nx; }
        const unsigned old = xb_add(&bar[XB_XSUB(b.x)], 1u);
        const unsigned gen = old / nloc;
        if (old + 1u == (gen + 1u) * nloc) {
            __builtin_amdgcn_fence(__ATOMIC_RELEASE, "agent");
            asm volatile("s_waitcnt vmcnt(0)" ::: "memory");
            const unsigned og = xb_add(&bar[XB_TOP], 1u);
            const unsigned tg = og / nx;
            if (og + 1u == (tg + 1u) * nx) xb_add(&bar[XB_TOPGEN], 1u);
            else XB_SPIN(xb_ld(&bar[XB_TOPGEN]) == tg, bar);
            __builtin_amdgcn_fence(__ATOMIC_ACQUIRE, "agent");
            xb_add(&bar[XB_XGEN(b.x)], 1u);
            asm volatile("s_waitcnt vmcnt(0)" ::: "memory");
        } else {
            XB_SPIN(xb_ld(&bar[XB_XGEN(b.x)]) == gen, bar);
            __builtin_amdgcn_fence(__ATOMIC_ACQUIRE, "agent");
            asm volatile("s_waitcnt vmcnt(0)" ::: "memory");
        }
    }
    __syncthreads();
}

struct Args { const float* in[17]; float* out; unsigned char* ws; int ph_lo, ph_hi; };
struct Ctx {
    LAS unsigned char* lds; int tid, lane, wave, G, bid;
    const float *x, *ln1, *w_in, *conv_w, *conv_b, *ga_w, *ga_b, *gx_w, *gx_b, *lam, *gn_w, *w_out, *ln2, *w_g, *w_u, *w_d, *fnw;
    float* out; unsigned char* ws;
};

struct TDesc { const float* W; bf16_t* WT; const float* ks; int K, N, mode, item; };
__device__ __forceinline__ void t_load(const TDesc& d, int lane, float (&v)[32], f32x4& s0, f32x4& s1) {
    const int nblk = d.N >> 5, kb = d.item / nblk, nb = d.item - kb * nblk, k0 = 64 * kb, n0 = 32 * nb;
    const float* p = d.W + (size_t)(k0 + (lane >> 5)) * d.N + n0 + (lane & 31);
    const size_t rs2 = (size_t)2 * d.N;
#pragma unroll
    for (int i = 0; i < 32; ++i) v[i] = __builtin_nontemporal_load(p + i * rs2);
    s0 = (f32x4){1.f, 1.f, 1.f, 1.f}; s1 = s0;
    if (d.ks) { const float* kp = d.ks + k0 + 8 * (lane & 7); s0 = *(const f32x4*)kp; s1 = *(const f32x4*)(kp + 4); }
}
__device__ __forceinline__ void t_store(const TDesc& d, int lane, const float (&v)[32], const f32x4 s0, const f32x4 s1, LAS float* scr) {
    const int nblk = d.N >> 5, kb = d.item / nblk, nb = d.item - kb * nblk, k0 = 64 * kb, n0 = 32 * nb;
#pragma unroll
    for (int i = 0; i < 32; ++i) { const int kk = 2 * i + (lane >> 5); scr[kk * 33 + (lane & 31)] = v[i]; }
    asm volatile("s_waitcnt lgkmcnt(0)" ::: "memory");
    const int c = lane & 7;
#pragma unroll
    for (int j = 0; j < 4; ++j) { const int n = (lane >> 3) + 8 * j; const LAS float* s = scr + (8 * c) * 33 + n;
        u32x4 o; o.x = pk2(s[0 * 33] * s0[0], s[1 * 33] * s0[1]); o.y = pk2(s[2 * 33] * s0[2], s[3 * 33] * s0[3]); o.z = pk2(s[4 * 33] * s1[0], s[5 * 33] * s1[1]); o.w = pk2(s[6 * 33] * s1[2], s[7 * 33] * s1[3]);
        const int ng = n0 + n;
        int drow = ng;
        if (d.mode == 1) drow = (ng >> 7) * 256 + (ng & 127);
        else if (d.mode == 2) drow = (ng >> 7) * 256 + 128 + (ng & 127);
        *(u32x4*)(d.WT + (size_t)drow * d.K + k0 + 8 * c) = o; }
    asm volatile("s_waitcnt lgkmcnt(0)" ::: "memory");
}
__device__ __forceinline__ bool p0_desc(const Ctx& F, int part, int it, TDesc& d) {
    constexpr int I_IN = (D_ / 64) * (DIN / 32), I_OUT = (D_ / 64) * (D_ / 32), I_G = (D_ / 64) * (DFF / 32), I_D = (DFF / 64) * (D_ / 32), I_LG = 8 * 2 * 4;
    d.ks = nullptr; d.mode = 0;
    if (part == 0) {
        if (it >= I_IN + 2 * I_LG) return false;
        int r = it;
        if (r < I_IN) { d.W = F.w_in; d.WT = (bf16_t*)(F.ws + WS_WIN); d.ks = F.ln1; d.K = D_; d.N = DIN; d.item = r; return true; } r -= I_IN;
        const bool isx = r >= I_LG; if (isx) r -= I_LG;
        const int blk = r >> 3;
        d.W = (isx ? F.gx_w : F.ga_w) + (size_t)blk * 16384; d.WT = (bf16_t*)(F.ws + (isx ? WS_GXT : WS_GAT)) + (size_t)blk * 16384; d.K = 128; d.N = 128; d.item = r & 7; return true;
    } else if (part == 1) {
        if (it >= I_OUT + 2 * I_G) return false;
        int r = it;
        if (r < I_OUT) { d.W = F.w_out; d.WT = (bf16_t*)(F.ws + WS_WOUT); d.K = D_; d.N = D_; d.item = r; return true; } r -= I_OUT;
        const bool isu = r >= I_G; if (isu) r -= I_G;
        d.W = isu ? F.w_u : F.w_g; d.WT = (bf16_t*)(F.ws + WS_WGU); d.ks = F.ln2; d.K = D_; d.N = DFF; d.mode = isu ? 2 : 1; d.item = r; return true;
    }
    if (it >= I_D) return false;
    d.W = F.w_d; d.WT = (bf16_t*)(F.ws + WS_WD); d.K = DFF; d.N = D_; d.item = it; return true;
}
__device__ __forceinline__ void x_load(const Ctx& F, int m, f32x4 (&v)[8]) {
    const f32x4* xr = (const f32x4*)(F.x + (size_t)m * D_) + F.lane;
#pragma unroll
    for (int j = 0; j < 8; ++j) v[j] = __builtin_nontemporal_load(xr + 64 * j);
}
__device__ __forceinline__ void x_store(const Ctx& F, int m, const f32x4 (&v)[8]) {
    float s = 0.f;
#pragma unroll
    for (int j = 0; j < 8; ++j) s += (v[j][0] * v[j][0] + v[j][1] * v[j][1]) + (v[j][2] * v[j][2] + v[j][3] * v[j][3]);
    s = wave_sum(s);
    if (F.lane == 0) ((float*)(F.ws + WS_RSTD1))[m] = 1.0f / sqrtf(s * (1.0f / D_) + EPS);
    u32x2* o8 = (u32x2*)((bf16_t*)F.out + (size_t)m * D_) + F.lane;
#pragma unroll
    for (int j = 0; j < 8; ++j) { u32x2 w; w.x = pk2(v[j][0], v[j][1]); w.y = pk2(v[j][2], v[j][3]); o8[64 * j] = w; }
}
__device__ __forceinline__ void p0_prologue(Ctx& F, int part, int gw, int NGW) {
    LAS float* scr = (LAS float*)(F.lds + F.wave * 8704);
    {
        TDesc dA, dB; float vA[32], vB[32]; f32x4 a0, a1, b0, b1;
        int it = gw;
        bool hA = p0_desc(F, part, it, dA);
        if (hA) t_load(dA, F.lane, vA, a0, a1);
        while (hA) {
            const bool hB = p0_desc(F, part, it + NGW, dB);
            if (hB) t_load(dB, F.lane, vB, b0, b1);
            t_store(dA, F.lane, vA, a0, a1, scr);
            if (!hB) break;
            hA = p0_desc(F, part, it + 2 * NGW, dA);
            if (hA) t_load(dA, F.lane, vA, a0, a1);
            t_store(dB, F.lane, vB, b0, b1, scr);
            it += 2 * NGW;
        }
    }
    if (part != 0) return;
    {
        f32x4 vA[8], vB[8];
        int m = gw;
        if (m < S_) x_load(F, m, vA);
        while (m < S_) {
            const int mb = m + NGW;
            if (mb < S_) x_load(F, mb, vB);
            x_store(F, m, vA);
            if (mb >= S_) break;
            m = mb + NGW;
            if (m < S_) x_load(F, m, vA);
            x_store(F, mb, vB);
        }
    }
}

template <bool FINAL>
__device__ __forceinline__ void p2_lru(Ctx& F, int cpart, int cbase, int cstep, int cslots) {
    const bf16_t* proj = (const bf16_t*)(F.ws + WS_PROJ);
    const bf16_t* GaT = (const bf16_t*)(F.ws + WS_GAT); const bf16_t* GxT = (const bf16_t*)(F.ws + WS_GXT);
    float* Atot = (float*)(F.ws + WS_ATOT); float* Hend = (float*)(F.ws + WS_HEND);
    const float* carry = (const float*)(F.ws + WS_CARRY); bf16_t* Y = (bf16_t*)(F.ws + WS_Y);
    LAS float* XC = (LAS float*)F.lds;
    LAS float* HB = (LAS float*)(F.lds + 33792);
    LAS bf16_t* HL = (LAS bf16_t*)(F.lds + 33792); LAS bf16_t* PL = (LAS bf16_t*)(F.lds + 51200);
    bf16_t* hlocB = (bf16_t*)F.out + (size_t)S_ * D_; bf16_t* pcumB = hlocB + (size_t)S_ * DLRU;
    const int w = F.wave, lane = F.lane, r16 = lane & 15, g4 = lane >> 4;
    int curn = -1; bf16x8 Ba[4], Bx[4]; float bar = 0.f, bxr = 0.f, kch = 0.f;
    float cw0[4] = {0.f, 0.f, 0.f, 0.f}, cw1[4] = {0.f, 0.f, 0.f, 0.f}; f32x2 cb = (f32x2){0.f, 0.f};
    unsigned xn[11];
    { const int it0 = F.bid; const int n0 = it0 & 7, tb = (it0 >> 3) * LCH + w * 8 - 3;
#pragma unroll
      for (int i = 0; i < 11; ++i) { const int t = tb + i; xn[i] = 0u; if (it0 < NLCH * 8 && t >= 0) xn[i] = *(const unsigned*)(proj + (size_t)t * DIN + n0 * 128 + 2 * lane); } }
    LAS float* cscr = (LAS float*)(F.lds + 69632 + w * 8704);
    int slot = 0;
    for (int it = F.bid; it < NLCH * 8; it += F.G, ++slot) {
        const int n = it & 7, chunk = it >> 3, t0 = chunk * LCH;
        const int chl = 16 * w + r16, ch = n * 128 + chl;
        TDesc cd; float cv[32]; f32x4 cs0, cs1;
        const bool hc = (slot < cslots) && p0_desc(F, cpart, cbase + slot * cstep, cd);
        if (n != curn) { curn = n;
#pragma unroll
            for (int kk = 0; kk < 4; ++kk) { Ba[kk] = *(const bf16x8*)(GaT + ((size_t)n * 128 + chl) * 128 + 32 * kk + 8 * g4); Bx[kk] = *(const bf16x8*)(GxT + ((size_t)n * 128 + chl) * 128 + 32 * kk + 8 * g4); }
            bar = F.ga_b[ch]; bxr = F.gx_b[ch];
            const float lm = F.lam[ch]; const float logsig = -log1pf(expf(-lm));
            kch = 8.0f * logsig;
#pragma unroll
            for (int k = 0; k < 4; ++k) { const f32x2 c2 = *(const f32x2*)(F.conv_w + k * DLRU + n * 128 + 2 * lane); cw0[k] = c2[0]; cw1[k] = c2[1]; }
            cb = *(const f32x2*)(F.conv_b + n * 128 + 2 * lane);
        }
        const int etok = F.tid >> 3, ec16 = (F.tid & 7) * 16;
        u32x4 gq0 = (u32x4){0u, 0u, 0u, 0u}, gq1 = gq0; float Hc = 0.f;
        if constexpr (FINAL) { const bf16_t* gp = proj + (size_t)(t0 + etok) * DIN + DLRU + n * 128 + ec16; gq0 = *(const u32x4*)gp; gq1 = *(const u32x4*)(gp + 8); Hc = carry[chunk * DLRU + ch]; }
        { const int cp = lane, tg = w;
          float xw0[11], xw1[11];
#pragma unroll
          for (int i = 0; i < 11; ++i) { xw0[i] = bf_lo(xn[i]); xw1[i] = bf_hi(xn[i]); }
#pragma unroll
          for (int j = 0; j < 8; ++j) { float y0 = cb[0], y1 = cb[1];
#pragma unroll
              for (int k = 0; k < 4; ++k) { y0 += cw0[k] * xw0[j + k]; y1 += cw1[k] * xw1[j + k]; }
              *(LAS f32x2*)(XC + (tg * 8 + j) * 132 + 2 * cp) = (f32x2){y0, y1}; }
        }
        __syncthreads();
        { const int itn = it + F.G; const int nn = itn & 7, tb = (itn >> 3) * LCH + w * 8 - 3;
          if (itn < NLCH * 8) {
#pragma unroll
            for (int i = 0; i < 11; ++i) xn[i] = *(const unsigned*)(proj + (size_t)(tb + i) * DIN + nn * 128 + 2 * lane); } }
        if (hc) t_load(cd, lane, cv, cs0, cs1);
        float Pc = 1.f;
#pragma unroll
        for (int m = 0; m < 4; ++m) {
            f32x4 ar = (f32x4){0.f, 0.f, 0.f, 0.f}, ax = (f32x4){0.f, 0.f, 0.f, 0.f};
#pragma unroll
            for (int kk = 0; kk < 4; ++kk) { const LAS float* xr = XC + (16 * m + r16) * 132 + 32 * kk + 8 * g4;
                const f32x4 x0 = *(const LAS f32x4*)xr, x1 = *(const LAS f32x4*)(xr + 4);
                u32x4 pw; pw.x = pk2(x0[0], x0[1]); pw.y = pk2(x0[2], x0[3]); pw.z = pk2(x1[0], x1[1]); pw.w = pk2(x1[2], x1[3]);
                const bf16x8 af = __builtin_bit_cast(bf16x8, pw);
                ar = __builtin_amdgcn_mfma_f32_16x16x32_bf16(af, Ba[kk], ar, 0, 0, 0);
                ax = __builtin_amdgcn_mfma_f32_16x16x32_bf16(af, Bx[kk], ax, 0, 0, 0); }
            float P[4], H[4];
#pragma unroll
            for (int jj = 0; jj < 4; ++jj) { const int tok = 16 * m + 4 * g4 + jj;
                const float xc = XC[tok * 132 + chl];
                const float r = sigm(ar[jj] + bar), ig = sigm(ax[jj] + bxr);
                const float la = kch * r;
                const float a = __builtin_amdgcn_exp2f(la * 1.4426950408889634f);
                const float z = 2.0f * la;
                const float om = z > -4e-3f ? -z * (1.f + z * (0.5f + z * (1.f / 6.f))) : __builtin_fmaf(-a, a, 1.0f);
                const float b = __builtin_amdgcn_sqrtf(fmaxf(om, 0.f)) * (ig * xc);
                if (jj == 0) { P[0] = a; H[0] = b; } else { P[jj] = a * P[jj - 1]; H[jj] = a * H[jj - 1] + b; } }
            float Pt = P[3], Ht = H[3];
            float Pq = __shfl_up(Pt, 16), Hq = __shfl_up(Ht, 16); if (g4 >= 1) { Ht = Pt * Hq + Ht; Pt = Pt * Pq; }
            Pq = __shfl_up(Pt, 32); Hq = __shfl_up(Ht, 32); if (g4 >= 2) { Ht = Pt * Hq + Ht; Pt = Pt * Pq; }
            float Pe = __shfl_up(Pt, 16), He = __shfl_up(Ht, 16); if (g4 == 0) { Pe = 1.f; He = 0.f; }
            if constexpr (FINAL) {
                const float Hpre = Pe * Hc + He;
#pragma unroll
                for (int jj = 0; jj < 4; ++jj) HB[(16 * m + 4 * g4 + jj) * 132 + chl] = P[jj] * Hpre + H[jj];
            } else {
                const float Hpre = Pe * Hc + He, Ppre = Pe * Pc;
#pragma unroll
                for (int jj = 0; jj < 4; ++jj) { const unsigned hp = pk2(P[jj] * Hpre + H[jj], P[jj] * Ppre);
                    HL[(16 * m + 4 * g4 + jj) * 136 + chl] = (bf16_t)(hp & 0xffffu); PL[(16 * m + 4 * g4 + jj) * 136 + chl] = (bf16_t)(hp >> 16); }
            }
            const float Ptile = __shfl(Pt, r16 + 48), Htile = __shfl(Ht, r16 + 48);
            Hc = Ptile * Hc + Htile; Pc = Ptile * Pc;
        }
        if constexpr (!FINAL) { if (g4 == 0) { Atot[chunk * DLRU + ch] = Pc; Hend[chunk * DLRU + ch] = Hc; } }
        __syncthreads();
        if constexpr (!FINAL) {
            const size_t go = (size_t)(t0 + etok) * DLRU + n * 128 + ec16;
            const u32x4 h0 = *(const LAS u32x4*)(HL + etok * 136 + ec16), h1 = *(const LAS u32x4*)(HL + etok * 136 + ec16 + 8);
            const u32x4 p0 = *(const LAS u32x4*)(PL + etok * 136 + ec16), p1 = *(const LAS u32x4*)(PL + etok * 136 + ec16 + 8);
            *(u32x4*)(hlocB + go) = h0; *(u32x4*)(hlocB + go + 8) = h1; *(u32x4*)(pcumB + go) = p0; *(u32x4*)(pcumB + go + 8) = p1;
        }
        if constexpr (FINAL) {
            const LAS float* hr = HB + etok * 132 + ec16;
            float hv[16], g[16];
#pragma unroll
            for (int q = 0; q < 4; ++q) { const f32x4 v = *(const LAS f32x4*)(hr + 4 * q); hv[4 * q] = v[0]; hv[4 * q + 1] = v[1]; hv[4 * q + 2] = v[2]; hv[4 * q + 3] = v[3]; }
#pragma unroll
            for (int q = 0; q < 4; ++q) { g[2 * q] = bf_lo(gq0[q]); g[2 * q + 1] = bf_hi(gq0[q]); g[8 + 2 * q] = bf_lo(gq1[q]); g[8 + 2 * q + 1] = bf_hi(gq1[q]); }
            float o[16];
#pragma unroll
            for (int j = 0; j < 16; ++j) { const float u = 0.7978845608028654f * (g[j] + 0.044715f * g[j] * g[j] * g[j]); o[j] = hv[j] * g[j] * sigm(2.0f * u); }
            u32x4 w0, w1;
#pragma unroll
            for (int q = 0; q < 4; ++q) { w0[q] = pk2(o[2 * q], o[2 * q + 1]); w1[q] = pk2(o[8 + 2 * q], o[8 + 2 * q + 1]); }
            bf16_t* yo = Y + (size_t)(t0 + etok) * D_ + n * 128 + ec16;
            *(u32x4*)yo = w0; *(u32x4*)(yo + 8) = w1;
        }
        if (hc) t_store(cd, lane, cv, cs0, cs1, cscr);
    }
}

__device__ __forceinline__ void rope8(const u32x4 a, const u32x4 b, const f32x4 c0, const f32x4 c1, const f32x4 s0, const f32x4 s1, float scale, u32x4& oa, u32x4& ob) {
    float x1[8], x2[8], c[8], s[8], o1[8], o2[8];
#pragma unroll
    for (int i = 0; i < 4; ++i) { x1[2 * i] = bf_lo(a[i]); x1[2 * i + 1] = bf_hi(a[i]); x2[2 * i] = bf_lo(b[i]); x2[2 * i + 1] = bf_hi(b[i]); c[i] = c0[i]; c[4 + i] = c1[i]; s[i] = s0[i]; s[4 + i] = s1[i]; }
#pragma unroll
    for (int i = 0; i < 8; ++i) { o1[i] = (x1[i] * c[i] - x2[i] * s[i]) * scale; o2[i] = (x1[i] * s[i] + x2[i] * c[i]) * scale; }
#pragma unroll
    for (int i = 0; i < 4; ++i) { oa[i] = pk2(o1[2 * i], o1[2 * i + 1]); ob[i] = pk2(o2[2 * i], o2[2 * i + 1]); }
}
struct RopeC { float hi[16], lo[16]; };
__device__ __forceinline__ void rope_init(RopeC& R, int g4) {
#pragma unroll
    for (int j = 0; j < 16; ++j) { const int f = 32 * (j >> 3) + 8 * g4 + (j & 7);
        const double c = exp2(-(double)f * (13.287712379549449 / 64.0)) * 0.15915494309189535;
        const float hh = (float)c; R.hi[j] = hh; R.lo[j] = (float)(c - (double)hh); }
}
template <int K2>
__device__ __forceinline__ void rope_cs(const RopeC& R, float tpos, f32x4& c0, f32x4& c1, f32x4& s0, f32x4& s1) {
#pragma unroll
    for (int i = 0; i < 8; ++i) { const float hh = R.hi[K2 * 8 + i], p = tpos * hh, e = __builtin_fmaf(tpos, hh, -p);
        const float r = __builtin_amdgcn_fractf(p) + (e + tpos * R.lo[K2 * 8 + i]);
        const float cv = __builtin_amdgcn_cosf(r), sv = __builtin_amdgcn_sinf(r);
        if (i < 4) { c0[i] = cv; s0[i] = sv; } else { c1[i - 4] = cv; s1[i - 4] = sv; } }
}
__device__ __forceinline__ float log2gamma(int h) { return log1pf(-exp2f(-5.0f - (float)h)) * 1.4426950408889634f; }

__device__ __forceinline__ void p2_ret(Ctx& F) {
    const bf16_t* proj = (const bf16_t*)(F.ws + WS_PROJ);
    bf16_t* kvT = (bf16_t*)(F.ws + WS_KV);
    LAS bf16_t* KT = (LAS bf16_t*)F.lds;
    LAS bf16_t* VT = (LAS bf16_t*)(F.lds + 34816);
    const int w = F.wave, lane = F.lane, r16 = lane & 15, g4 = lane >> 4;
    const int tl = 16 * w + r16;
    RopeC RC; rope_init(RC, g4);
    u32x4 kc[4], vc[4];
#pragma unroll
    for (int kk = 0; kk < 4; ++kk) { kc[kk] = (u32x4){0u, 0u, 0u, 0u}; vc[kk] = kc[kk]; }
    if (F.bid < NRCH * 8) { const bf16_t* prow = proj + (size_t)((F.bid >> 3) * RCH + tl) * DIN + (F.bid & 7) * 128 + 8 * g4;
#pragma unroll
        for (int kk = 0; kk < 4; ++kk) { kc[kk] = *(const u32x4*)(prow + 3072 + 32 * kk); vc[kk] = *(const u32x4*)(prow + 4096 + 32 * kk); } }
    for (int it = F.bid; it < NRCH * 8; it += F.G) {
        const int h = it & 7, n = it >> 3, t0 = n * RCH;
        const float lg2 = log2gamma(h);
        u32x4 kr[4];
        { f32x4 c0, c1, s0, s1; const float tpos = (float)(t0 + tl);
          rope_cs<0>(RC, tpos, c0, c1, s0, s1); rope8(kc[0], kc[2], c0, c1, s0, s1, 0.08838834764831845f, kr[0], kr[2]);
          rope_cs<1>(RC, tpos, c0, c1, s0, s1); rope8(kc[1], kc[3], c0, c1, s0, s1, 0.08838834764831845f, kr[1], kr[3]); }
        const float zeta = __builtin_amdgcn_exp2f((float)(127 - tl) * lg2);
#pragma unroll
        for (int kk = 0; kk < 4; ++kk)
#pragma unroll
            for (int i = 0; i < 4; ++i) { const int d = 32 * kk + 8 * g4 + 2 * i;
                KT[d * 136 + tl] = (bf16_t)(kr[kk][i] & 0xffffu); KT[(d + 1) * 136 + tl] = (bf16_t)(kr[kk][i] >> 16);
                const unsigned vz = pk2(bf_lo(vc[kk][i]) * zeta, bf_hi(vc[kk][i]) * zeta);
                VT[d * 136 + tl] = (bf16_t)(vz & 0xffffu); VT[(d + 1) * 136 + tl] = (bf16_t)(vz >> 16); }
        __syncthreads();
        { const int itn = it + F.G;
          if (itn < NRCH * 8) { const bf16_t* prow = proj + (size_t)((itn >> 3) * RCH + tl) * DIN + (itn & 7) * 128 + 8 * g4;
#pragma unroll
            for (int kk = 0; kk < 4; ++kk) { kc[kk] = *(const u32x4*)(prow + 3072 + 32 * kk); vc[kk] = *(const u32x4*)(prow + 4096 + 32 * kk); } } }
        bf16x8 af[4];
#pragma unroll
        for (int kk = 0; kk < 4; ++kk) af[kk] = *(const LAS bf16x8*)(KT + (16 * w + r16) * 136 + 32 * kk + 8 * g4);
        bf16_t* dst = kvT + ((size_t)(n * 8 + h) * 128 + r16) * 128 + 16 * w + 4 * g4;
#pragma unroll
        for (int ne = 0; ne < 8; ++ne) { f32x4 acc = (f32x4){0.f, 0.f, 0.f, 0.f};
#pragma unroll
            for (int kk = 0; kk < 4; ++kk) { const bf16x8 bfr = *(const LAS bf16x8*)(VT + (16 * ne + r16) * 136 + 32 * kk + 8 * g4); acc = __builtin_amdgcn_mfma_f32_16x16x32_bf16(af[kk], bfr, acc, 0, 0, 0); }
            u32x2 o; o.x = pk2_sw(acc[0], acc[1]); o.y = pk2_sw(acc[2], acc[3]);
            *(u32x2*)(dst + (size_t)(16 * ne) * 128) = o; }
        __syncthreads();
    }
}

__device__ __forceinline__ void p3_carries(Ctx& F) {
    const int gw = F.wave * F.G + F.bid, NGW = F.G * NWAVES, lane = F.lane;
    const bf16_t* kvT = (const bf16_t*)(F.ws + WS_KV); bf16_t* Rp = (bf16_t*)(F.ws + WS_RP);
    const float* Atot = (const float*)(F.ws + WS_ATOT); const float* Hend = (const float*)(F.ws + WS_HEND); float* carry = (float*)(F.ws + WS_CARRY);
    constexpr int NRT = 8 * 128 * 128 / 128;
    constexpr int NLT = DLRU / 8;
    for (int task = gw; task < NRT + NLT; task += NGW) {
        if (task < NRT) {
            const int e2 = task * 128 + 2 * lane, h = e2 >> 14;
            const float gC = exp2f(128.0f * log2gamma(h));
            unsigned kv[NRCH];
#pragma unroll
            for (int j = 0; j < NRCH; ++j) kv[j] = *(const unsigned*)(kvT + (size_t)j * 131072 + e2);
            float r0 = 0.f, r1 = 0.f;
#pragma unroll
            for (int j = 0; j < NRCH; ++j) { *(unsigned*)(Rp + (size_t)j * 131072 + e2) = pk2(r0, r1); r0 = r0 * gC + bf_lo(kv[j]); r1 = r1 * gC + bf_hi(kv[j]); }
        } else {
            const int ch = (task - NRT) * 8 + (lane & 7), seg = lane >> 3, c0 = seg * 16;
            float av[16], hv[16];
#pragma unroll
            for (int j = 0; j < 16; ++j) { av[j] = Atot[(c0 + j) * DLRU + ch]; hv[j] = Hend[(c0 + j) * DLRU + ch]; }
            float A = 1.f, H = 0.f;
#pragma unroll
            for (int j = 0; j < 16; ++j) { H = av[j] * H + hv[j]; A = av[j] * A; }
#pragma unroll
            for (int o = 8; o < 64; o <<= 1) { const float Ap = __shfl_up(A, o), Hp = __shfl_up(H, o); if (lane >= o) { H = A * Hp + H; A = A * Ap; } }
            float Hc = __shfl_up(H, 8); if (seg == 0) Hc = 0.f;
#pragma unroll
            for (int j = 0; j < 16; ++j) { carry[(c0 + j) * DLRU + ch] = Hc; Hc = av[j] * Hc + hv[j]; }
        }
    }
}

__device__ __forceinline__ void p4_ret_preload(Ctx& F, u32x4 (&qc)[4], u32x4 (&kc)[4], u32x4 (&vc)[4], u32x4 (&gq)[4]) {
    const bf16_t* proj = (const bf16_t*)(F.ws + WS_PROJ);
    const int w = F.wave, lane = F.lane, r16 = lane & 15, g4 = lane >> 4, orow = lane >> 2, ocol = (lane & 3) * 32, tl = 16 * w + r16;
#pragma unroll
    for (int kk = 0; kk < 4; ++kk) { qc[kk] = (u32x4){0u, 0u, 0u, 0u}; kc[kk] = qc[kk]; vc[kk] = qc[kk]; gq[kk] = qc[kk]; }
    if (F.bid < NRCH * 8) { const int h0 = F.bid & 7, tb = (F.bid >> 3) * RCH;
        const bf16_t* prow = proj + (size_t)(tb + tl) * DIN + h0 * 128 + 8 * g4;
#pragma unroll
        for (int kk = 0; kk < 4; ++kk) { qc[kk] = *(const u32x4*)(prow + 2048 + 32 * kk); kc[kk] = *(const u32x4*)(prow + 3072 + 32 * kk); vc[kk] = *(const u32x4*)(prow + 4096 + 32 * kk); }
        const bf16_t* gp = proj + (size_t)(tb + 16 * w + orow) * DIN + 5120 + h0 * 128 + ocol;
#pragma unroll
        for (int i = 0; i < 4; ++i) gq[i] = *(const u32x4*)(gp + 8 * i); }
}
__device__ __forceinline__ void p4_ret(Ctx& F, u32x4 (&qc)[4], u32x4 (&kc)[4], u32x4 (&vc)[4], u32x4 (&gq)[4]) {
    const bf16_t* proj = (const bf16_t*)(F.ws + WS_PROJ); bf16_t* Y = (bf16_t*)(F.ws + WS_Y);
    const bf16_t* Rp = (const bf16_t*)(F.ws + WS_RP);
    LAS bf16_t* KS = (LAS bf16_t*)F.lds;
    LAS bf16_t* VT = (LAS bf16_t*)(F.lds + 34816);
    LAS unsigned char* RL = F.lds + 104448;
    const int w = F.wave, lane = F.lane, r16 = lane & 15, g4 = lane >> 4;
    LAS bf16_t* PS = (LAS bf16_t*)(F.lds + 69632) + w * (16 * 136);
    const int orow = lane >> 2, ocol = (lane & 3) * 32;
    const int tl = 16 * w + r16;
    RopeC RC; rope_init(RC, g4);
    for (int it = F.bid; it < NRCH * 8; it += F.G) {
        const int h = it & 7, n = it >> 3, t0 = n * RCH;
        const float lg2 = log2gamma(h);
        { const char* rg = (const char*)(Rp + (size_t)(n * 8 + h) * 16384);
#pragma unroll
          for (int i = 0; i < 4; ++i) { const int e = i * 32 + w * 4 + (lane >> 4), pos = lane & 15;
              __builtin_amdgcn_global_load_lds((const unsigned*)(rg + e * 256 + ((pos ^ (e & 15)) * 16)), (LAS unsigned*)(RL + i * 8192 + w * 1024), 16, 0, 0); } }
        u32x4 qf[4], go[4];
        {
            u32x4 kr[4];
            { f32x4 c0, c1, s0, s1; const float tpos = (float)(t0 + tl);
              rope_cs<0>(RC, tpos, c0, c1, s0, s1); rope8(qc[0], qc[2], c0, c1, s0, s1, 1.0f, qf[0], qf[2]); rope8(kc[0], kc[2], c0, c1, s0, s1, 0.08838834764831845f, kr[0], kr[2]);
              rope_cs<1>(RC, tpos, c0, c1, s0, s1); rope8(qc[1], qc[3], c0, c1, s0, s1, 1.0f, qf[1], qf[3]); rope8(kc[1], kc[3], c0, c1, s0, s1, 0.08838834764831845f, kr[1], kr[3]); }
#pragma unroll
            for (int kk = 0; kk < 4; ++kk) { *(LAS u32x4*)(KS + tl * 136 + 32 * kk + 8 * g4) = kr[kk];
#pragma unroll
                for (int i = 0; i < 4; ++i) { const int e = 32 * kk + 8 * g4 + 2 * i; VT[e * 136 + tl] = (bf16_t)(vc[kk][i] & 0xffffu); VT[(e + 1) * 136 + tl] = (bf16_t)(vc[kk][i] >> 16); } }
#pragma unroll
            for (int i = 0; i < 4; ++i) go[i] = gq[i];
        }
        asm volatile("s_waitcnt vmcnt(0)" ::: "memory");
        __syncthreads();
        { const int itn = it + F.G;
          if (itn < NRCH * 8) { const int hn = itn & 7, tb = (itn >> 3) * RCH;
            const bf16_t* prow = proj + (size_t)(tb + tl) * DIN + hn * 128 + 8 * g4;
#pragma unroll
            for (int kk = 0; kk < 4; ++kk) { qc[kk] = *(const u32x4*)(prow + 2048 + 32 * kk); kc[kk] = *(const u32x4*)(prow + 3072 + 32 * kk); vc[kk] = *(const u32x4*)(prow + 4096 + 32 * kk); }
            const bf16_t* gp = proj + (size_t)(tb + 16 * w + orow) * DIN + 5120 + hn * 128 + ocol;
#pragma unroll
            for (int i = 0; i < 4; ++i) gq[i] = *(const u32x4*)(gp + 8 * i); } }
#pragma unroll
        for (int nn = 0; nn < 8; ++nn) {
            if (nn <= w) {
                f32x4 acc = (f32x4){0.f, 0.f, 0.f, 0.f};
#pragma unroll
                for (int kk = 0; kk < 4; ++kk) { const bf16x8 kf = *(const LAS bf16x8*)(KS + (16 * nn + r16) * 136 + 32 * kk + 8 * g4); acc = __builtin_amdgcn_mfma_f32_16x16x32_bf16(__builtin_bit_cast(bf16x8, qf[kk]), kf, acc, 0, 0, 0); }
#pragma unroll
                for (int jj = 0; jj < 4; ++jj) { const int diff = (16 * w + 4 * g4 + jj) - (16 * nn + r16);
                    const float p = diff >= 0 ? acc[jj] * __builtin_amdgcn_exp2f((float)diff * lg2) : 0.f;
                    PS[(4 * g4 + jj) * 136 + 16 * nn + r16] = (bf16_t)(pk2(p, 0.f) & 0xffffu); }
            } else if (nn <= (w | 1)) {
#pragma unroll
                for (int jj = 0; jj < 4; ++jj) PS[(4 * g4 + jj) * 136 + 16 * nn + r16] = (bf16_t)0;
            }
        }
        asm volatile("s_waitcnt lgkmcnt(0)" ::: "memory");
        f32x4 O[8];
#pragma unroll
        for (int ne = 0; ne < 8; ++ne) O[ne] = (f32x4){0.f, 0.f, 0.f, 0.f};
#pragma unroll
        for (int k2 = 0; k2 < 4; ++k2) {
            if (k2 <= (w >> 1)) {
                const bf16x8 pf = *(const LAS bf16x8*)(PS + r16 * 136 + 32 * k2 + 8 * g4);
#pragma unroll
                for (int ne = 0; ne < 8; ++ne) { const bf16x8 vf = *(const LAS bf16x8*)(VT + (16 * ne + r16) * 136 + 32 * k2 + 8 * g4); O[ne] = __builtin_amdgcn_mfma_f32_16x16x32_bf16(pf, vf, O[ne], 0, 0, 0); }
            }
        }
        float xi[4];
#pragma unroll
        for (int jj = 0; jj < 4; ++jj) xi[jj] = __builtin_amdgcn_exp2f((float)(16 * w + 4 * g4 + jj + 1) * lg2);
#pragma unroll
        for (int ne = 0; ne < 8; ++ne) { f32x4 cx = (f32x4){0.f, 0.f, 0.f, 0.f};
#pragma unroll
            for (int kk = 0; kk < 4; ++kk) { const bf16x8 rf = *(const LAS bf16x8*)(RL + (16 * ne + r16) * 256 + (((4 * kk + g4) ^ r16) * 16)); cx = __builtin_amdgcn_mfma_f32_16x16x32_bf16(__builtin_bit_cast(bf16x8, qf[kk]), rf, cx, 0, 0, 0); }
#pragma unroll
            for (int jj = 0; jj < 4; ++jj) O[ne][jj] += xi[jj] * cx[jj]; }
        float gnw[8];
#pragma unroll
        for (int ne = 0; ne < 8; ++ne) gnw[ne] = F.gn_w[h * 128 + 16 * ne + r16];
#pragma unroll
        for (int jj = 0; jj < 4; ++jj) {
            float s = 0.f;
#pragma unroll
            for (int ne = 0; ne < 8; ++ne) s += O[ne][jj];
            s += __shfl_xor(s, 1); s += __shfl_xor(s, 2); s += __shfl_xor(s, 4); s += __shfl_xor(s, 8);
            const float mu = s * (1.0f / 128.0f); float q = 0.f;
#pragma unroll
            for (int ne = 0; ne < 8; ++ne) { const float d = O[ne][jj] - mu; q += d * d; }
            q += __shfl_xor(q, 1); q += __shfl_xor(q, 2); q += __shfl_xor(q, 4); q += __shfl_xor(q, 8);
            const float rstd = __builtin_amdgcn_rsqf(q * (1.0f / 128.0f) + EPS);
#pragma unroll
            for (int ne = 0; ne < 8; ++ne) { const float on = (O[ne][jj] - mu) * rstd * gnw[ne];
                PS[(4 * g4 + jj) * 136 + 16 * ne + r16] = (bf16_t)(pk2(on, 0.f) & 0xffffu); }
        }
        asm volatile("s_waitcnt lgkmcnt(0)" ::: "memory");
        { bf16_t* yo = Y + (size_t)(t0 + 16 * w + orow) * D_ + DLRU + h * 128 + ocol;
#pragma unroll
          for (int i = 0; i < 4; ++i) { const u32x4 ov = *(const LAS u32x4*)(PS + orow * 136 + ocol + 8 * i); u32x4 wv;
#pragma unroll
              for (int j = 0; j < 4; ++j) { const float g0 = bf_lo(go[i][j]), g1 = bf_hi(go[i][j]); wv[j] = pk2(bf_lo(ov[j]) * (g0 * sigm(g0)), bf_hi(ov[j]) * (g1 * sigm(g1))); }
              *(u32x4*)(yo + 8 * i) = wv; } }
        __syncthreads();
    }
}

__device__ __forceinline__ void p4_lru_fix(Ctx& F) {
    const bf16_t* proj = (const bf16_t*)(F.ws + WS_PROJ); bf16_t* Y = (bf16_t*)(F.ws + WS_Y);
    const bf16_t* hlocB = (const bf16_t*)F.out + (size_t)S_ * D_; const bf16_t* pcumB = hlocB + (size_t)S_ * DLRU;
    const float* carry = (const float*)(F.ws + WS_CARRY);
    for (int i = F.bid * NTHR + F.tid; i < S_ * (DLRU / 8); i += F.G * NTHR) {
        const int t = i >> 7, c = (i & 127) * 8;
        const u32x4 hl = *(const u32x4*)(hlocB + (size_t)t * DLRU + c), pc = *(const u32x4*)(pcumB + (size_t)t * DLRU + c), gw = *(const u32x4*)(proj + (size_t)t * DIN + DLRU + c);
        const float* cp = carry + (size_t)(t >> 6) * DLRU + c; const f32x4 c0 = *(const f32x4*)cp, c1 = *(const f32x4*)(cp + 4);
        u32x4 o;
#pragma unroll
        for (int q = 0; q < 4; ++q) { const float ca = q < 2 ? c0[2 * q] : c1[2 * q - 4], cb = q < 2 ? c0[2 * q + 1] : c1[2 * q - 3];
            const float ha = bf_lo(hl[q]) + bf_lo(pc[q]) * ca, hb = bf_hi(hl[q]) + bf_hi(pc[q]) * cb, ga = bf_lo(gw[q]), gb = bf_hi(gw[q]);
            const float ua = 0.7978845608028654f * (ga + 0.044715f * ga * ga * ga), ub = 0.7978845608028654f * (gb + 0.044715f * gb * gb * gb);
            o[q] = pk2(ha * ga * sigm(2.0f * ua), hb * gb * sigm(2.0f * ub)); }
        *(u32x4*)(Y + (size_t)t * D_ + c) = o;
    }
}

__device__ __forceinline__ void p8_final(Ctx& F) {
    const int gw = F.bid * NWAVES + F.wave, NGW = F.G * NWAVES;
    const float* ss3 = (const float*)(F.ws + WS_SS3);
    for (int m = gw; m < S_; m += NGW) {
        const f32x4 p0 = *(const f32x4*)(ss3 + (size_t)m * 8), p1 = *(const f32x4*)(ss3 + (size_t)m * 8 + 4);
        const float tot = ((p0[0] + p0[1]) + (p0[2] + p0[3])) + ((p1[0] + p1[1]) + (p1[2] + p1[3]));
        const float rstd = 1.0f / sqrtf(tot * (1.0f / D_) + EPS);
        f32x4* xr = (f32x4*)(F.out + (size_t)m * D_) + F.lane; const f32x4* wr = (const f32x4*)F.fnw + F.lane;
#pragma unroll
        for (int j = 0; j < 8; ++j) { const f32x4 v = xr[64 * j], wv = wr[64 * j]; xr[64 * j] = v * rstd * wv; }
    }
}

__global__ void __launch_bounds__(NTHR, 2) hymba_fwd(Args args) {
    extern __shared__ __attribute__((aligned(16))) unsigned char lds_raw[];
    Ctx F;
    F.lds = (LAS unsigned char*)lds_raw;
    F.tid = threadIdx.x; F.lane = F.tid & 63; F.wave = __builtin_amdgcn_readfirstlane(F.tid >> 6); F.G = gridDim.x; F.bid = blockIdx.x;
    F.x = args.in[0]; F.ln1 = args.in[1]; F.w_in = args.in[2]; F.conv_w = args.in[3]; F.conv_b = args.in[4]; F.ga_w = args.in[5]; F.ga_b = args.in[6]; F.gx_w = args.in[7];
    F.gx_b = args.in[8]; F.lam = args.in[9]; F.gn_w = args.in[10]; F.w_out = args.in[11]; F.ln2 = args.in[12]; F.w_g = args.in[13]; F.w_u = args.in[14]; F.w_d = args.in[15]; F.fnw = args.in[16];
    F.out = args.out; F.ws = args.ws;
    const int lo = args.ph_lo, hi = args.ph_hi;
#define IN(k) (lo <= (k) && (k) < hi)
#define SEAM(k) do { if (IN(k) && IN((k) + 1)) { xcd_barrier(bar); } } while (0)
    unsigned char* ws = args.ws;
    XcdBarrier bar; bar.bar = (unsigned*)(ws + WS_BAR); bar.x = 0; bar.st = (volatile LAS unsigned*)(F.lds + LDS_CTL);
    if (hi - lo > 1) {
        if (F.tid < 4) ((LAS unsigned*)(F.lds + LDS_CTL))[F.tid] = 0u;
        __syncthreads();
        bar = xcd_barrier_post((unsigned*)(ws + WS_BAR), (volatile LAS unsigned*)(F.lds + LDS_CTL));
    }
    if (lo == 12345) cg::this_grid().sync();

    if (IN(0)) { p0_prologue(F, 0, F.bid * NWAVES + F.wave, F.G * NWAVES); }
    SEAM(0);
    if (IN(1)) {
        pg8::Gemm g{(const bf16_t*)F.out, (const bf16_t*)(ws + WS_WIN), S_, DIN, D_}; pg8::StaticOrder S; S.init(S_, DIN, F.G, F.bid);
        pg8::EpiProj E{(bf16_t*)(ws + WS_PROJ), DIN, (const float*)(ws + WS_RSTD1)};
        pg8::gemm_phase<pg8::EpiProj, pg8::StaticOrder, true, true>(F.lds, g, S, E);
        if (REP_MASK & 2) pg8::gemm_phase<pg8::EpiProj, pg8::StaticOrder, true, true>(F.lds, g, S, E);
    }
    SEAM(1);
    if (IN(2)) { p2_lru<false>(F, 1, F.bid * NWAVES + F.wave, F.G * NWAVES, 4);   p2_ret(F); }
    SEAM(2);
    u32x4 pq[4], pk[4], pv[4], pg[4];
    if (IN(3)) { p4_ret_preload(F, pq, pk, pv, pg); p3_carries(F); }
    SEAM(3);
    if (IN(4)) { if (!IN(3)) p4_ret_preload(F, pq, pk, pv, pg); p4_ret(F, pq, pk, pv, pg);
        p4_lru_fix(F);
        p0_prologue(F, 1, (F.bid + 4 * F.G) * NWAVES + F.wave, F.G * NWAVES); }
    SEAM(4);
    if (IN(5)) {
        pg8::Gemm g{(const bf16_t*)(ws + WS_Y), (const bf16_t*)(ws + WS_WOUT), S_, D_, D_}; pg8::StaticOrder S; S.init(S_, D_, F.G, F.bid);
        pg8::EpiResid E{(const bf16_t*)F.out, nullptr, (bf16_t*)(ws + WS_H1B), D_, (float*)(ws + WS_SS2)};
        pg8::gemm_phase<pg8::EpiResid, pg8::StaticOrder, false, true>(F.lds, g, S, E);
        if (REP_MASK & 32) pg8::gemm_phase<pg8::EpiResid, pg8::StaticOrder, false, true>(F.lds, g, S, E);
    }
    SEAM(5);
    if (IN(6)) {
        pg8::Gemm g{(const bf16_t*)(ws + WS_H1B), (const bf16_t*)(ws + WS_WGU), S_, NGU, D_}; pg8::StaticOrder S; S.init(S_, NGU, F.G, F.bid);
        pg8::EpiSwiglu E{(bf16_t*)(ws + WS_FF), DFF, (const float*)(ws + WS_SS2)};
        pg8::gemm_phase<pg8::EpiSwiglu, pg8::StaticOrder, true, true>(F.lds, g, S, E);
        if (REP_MASK & 64) pg8::gemm_phase<pg8::EpiSwiglu, pg8::StaticOrder, true, true>(F.lds, g, S, E);
        const int nun = (S_ / 256) * (NGU / 256), full = nun / F.G, rem = nun % F.G;
        if (rem == 0) p0_prologue(F, 2, F.bid * NWAVES + F.wave, F.G * NWAVES);
        else if (F.bid >= rem) p0_prologue(F, 2, (F.bid - rem) * NWAVES + F.wave, (F.G - rem) * NWAVES);
        (void)full;
    }
    SEAM(6);
    if (IN(7)) {
        pg8::Gemm g{(const bf16_t*)(ws + WS_FF), (const bf16_t*)(ws + WS_WD), S_, D_, DFF}; pg8::StaticOrder S; S.init(S_, D_, F.G, F.bid);
        if (REP_MASK & 128) { pg8::EpiNull E{(float*)(ws + WS_SS2)}; pg8::gemm_phase<pg8::EpiNull, pg8::StaticOrder, false, true>(F.lds, g, S, E); }
        if (hi - lo > 1) {
            pg8::EpiFinal E{(const bf16_t*)(ws + WS_H1B), F.out, D_, (float*)(ws + WS_SS3), (unsigned*)(ws + WS_PCNT), F.fnw, (unsigned*)(ws + WS_PCNT + 32 * 256)};
            pg8::gemm_phase<pg8::EpiFinal, pg8::StaticOrder, false, true>(F.lds, g, S, E);
        } else {
            pg8::EpiResid E{(const bf16_t*)(ws + WS_H1B), F.out, nullptr, D_, (float*)(ws + WS_SS3)};
            pg8::gemm_phase<pg8::EpiResid, pg8::StaticOrder, false, true>(F.lds, g, S, E);
        }
    }
    if (hi - lo <= 1) { if (IN(8)) { p8_final(F); } }
#undef IN
#undef SEAM
}

extern "C" void kernel_launch(void* const* d_in, const int* in_sizes, int n_in, void* d_out, int out_size, void* d_ws, size_t ws_size, hipStream_t stream) {
    static int grid = 0;
    if (grid == 0) {
        if (n_in != 17 || out_size != S_ * D_ || ws_size < WS_END) { fprintf(stderr, "kernel_launch: unexpected shapes: n_in %d out %d ws %zu (need %zu)\n", n_in, out_size, ws_size, (size_t)WS_END); grid = -1; return; }
        int dev = 0, cus = 0, per_cu = 0;
        (void)hipGetDevice(&dev); (void)hipDeviceGetAttribute(&cus, hipDeviceAttributeMultiprocessorCount, dev);
        if (hipFuncSetAttribute((const void*)hymba_fwd, hipFuncAttributeMaxDynamicSharedMemorySize, LDS_BYTES) != hipSuccess) { fprintf(stderr, "kernel_launch: hipFuncSetAttribute failed\n"); grid = -1; return; }
        (void)hipOccupancyMaxActiveBlocksPerMultiprocessor(&per_cu, (const void*)hymba_fwd, NTHR, LDS_BYTES);
        (void)hipGetLastError();
        if (per_cu < 1) { fprintf(stderr, "kernel_launch: occupancy query says %d blocks per CU\n", per_cu); per_cu = 1; }
        grid = cus;
        if (grid != 256) fprintf(stderr, "kernel_launch: grid %d != 256: the residual GEMM phases need one unit per workgroup\n", grid);
    }
    if (grid < 0) return;
    Args a{};
    for (int i = 0; i < 17; ++i) a.in[i] = (const float*)d_in[i];
    a.out = (float*)d_out; a.ws = (unsigned char*)d_ws;
#if MK_ONE_LAUNCH
    if (hipMemsetAsync((char*)d_ws + WS_BAR, 0, CTL_ZERO_BYTES, stream) != hipSuccess) { fprintf(stderr, "kernel_launch: memset of barrier words failed\n"); return; }
    a.ph_lo = 0; a.ph_hi = 9;
    void* kargs[] = {&a};
    hipError_t e = hipLaunchCooperativeKernel((const void*)hymba_fwd, dim3(grid), dim3(NTHR), kargs, LDS_BYTES, stream);
    if (e != hipSuccess) fprintf(stderr, "kernel_launch: cooperative launch failed: %s (grid %d)\n", hipGetErrorString(e), grid);
#else
    for (int p = 0; p < 9; ++p) { a.ph_lo = p; a.ph_hi = p + 1; hipLaunchKernelGGL(hymba_fwd, dim3(grid), dim3(NTHR), LDS_BYTES, stream, a); }
#endif
}
```

```cpp
#include <hip/hip_runtime.h>
#include <hip/hip_cooperative_groups.h>
#include <cstdio>
#include <cstdint>
namespace cg = cooperative_groups;

#ifndef REP_MASK
#define REP_MASK 0
#endif
#ifndef MK_ONE_LAUNCH
#define MK_ONE_LAUNCH 1
#endif

#define LAS __attribute__((address_space(3)))
typedef unsigned short bf16_t;
typedef short bf16x8 __attribute__((ext_vector_type(8)));
typedef float f32x4 __attribute__((ext_vector_type(4)));
typedef float f32x2 __attribute__((ext_vector_type(2)));
typedef unsigned u32x4 __attribute__((ext_vector_type(4)));
typedef unsigned u32x2 __attribute__((ext_vector_type(2)));

constexpr int S_ = 8192, D_ = 2048, DIN = 6144, DLRU = 1024, DRET = 1024, DFF = 5632, NGU = 2 * DFF;
constexpr int NWAVES = 8, NTHR = 512;
constexpr float EPS = 1e-6f;
constexpr int LCH = 64;
constexpr int NLCH = S_ / LCH;
constexpr int RCH = 128, NRCH = S_ / RCH;
constexpr size_t MiB = 1u << 20;
constexpr size_t WS_RSTD1 = 0, WS_SS2 = 64 * 1024, WS_SS3 = 320 * 1024, WS_GAT = 576 * 1024, WS_GXT = 832 * 1024,
                 WS_ATOT = 1088 * 1024, WS_HEND = 1600 * 1024, WS_CARRY = 2112 * 1024;
constexpr size_t WS_ROPEC = 4 * MiB, WS_ROPES = 6 * MiB;
constexpr size_t WS_WOUT = 8 * MiB, WS_WGU = 16 * MiB, WS_WD = 60 * MiB, WS_PROJ = 82 * MiB;
constexpr size_t WS_WIN = 178 * MiB, WS_XB = 202 * MiB;
constexpr size_t WS_KV = 178 * MiB, WS_RP = 210 * MiB;
constexpr size_t WS_Y = 226 * MiB;
constexpr size_t WS_H1B = 82 * MiB, WS_FF = 114 * MiB;
constexpr size_t WS_END = 258 * MiB;
constexpr size_t WS_BAR = 2688 * 1024;
constexpr size_t WS_PCNT = WS_BAR + 16 * 1024;
constexpr size_t CTL_ZERO_BYTES = 16 * 1024 + 32 * 256 + 256;
constexpr int LDS_CTL = 163840 - 256;
constexpr int LDS_BYTES = 163840;

__device__ __forceinline__ unsigned pk2(float lo, float hi) { unsigned r; asm volatile("v_cvt_pk_bf16_f32 %0, %1, %2" : "=v"(r) : "v"(lo), "v"(hi)); return r; }
__device__ __forceinline__ unsigned pk2_sw(float lo, float hi) { unsigned a = __float_as_uint(lo), b = __float_as_uint(hi); a += 0x7fffu + ((a >> 16) & 1u); b += 0x7fffu + ((b >> 16) & 1u); return (a >> 16) | (b & 0xffff0000u); }
__device__ __forceinline__ float bf_lo(unsigned w) { return __uint_as_float(w << 16); }
__device__ __forceinline__ float bf_hi(unsigned w) { return __uint_as_float(w & 0xffff0000u); }
__device__ __forceinline__ float sigm(float z) { return __builtin_amdgcn_rcpf(1.f + __builtin_amdgcn_exp2f(-1.4426950408889634f * z)); }
__device__ __forceinline__ float wave_sum(float v) {
#pragma unroll
    for (int o = 1; o < 64; o <<= 1) v += __shfl_xor(v, o);
    return v;
}

namespace pg8 {
constexpr int BM = 256, BK = 64, HALF = 128, HTB = HALF * BK * 2, STAGE_BYTES = 8 * HTB, NXCD = 8, WGM = 8;
__host__ __device__ __forceinline__ int lds_byte(int r, int c) { const int st = (r >> 4) * 2 + (c >> 5), rr = r & 15, cc = c & 31, ob = rr * 64 + cc * 2; return st * 1024 + (ob ^ (((ob >> 9) & 1) << 5)); }
__host__ __device__ __forceinline__ void stage_rc(int b, int& R, int& C) { const int st = b / 1024, sb = b % 1024, swz = sb ^ (((sb >> 9) & 1) << 5); R = (st >> 1) * 16 + swz / 64; C = (st & 1) * 32 + (swz % 64) / 2; }
__host__ __device__ __forceinline__ int perm32(int rho) { const int n = rho >> 4, i = rho & 15; return 8 * (i >> 2) + 4 * n + (i & 3); }
struct Unit { int pm, pn; };
struct Gemm { const bf16_t* A; const bf16_t* Bt; int M, N, K; };
struct StaticOrder {
    int nM, nN, nwg, G, c;
    __host__ __device__ void init(int M, int N, int G_, int c_) { nM = M / BM; nN = N / BM; nwg = nM * nN; G = G_; c = c_; }
    __host__ __device__ bool next(int i, Unit& u) const {
        const long L = (long)i * G + c; if (L >= nwg) return false;
        int wgid = (int)L; { const int q = nwg / NXCD, r = nwg % NXCD, xcd = wgid % NXCD, off = wgid / NXCD; wgid = (xcd < r ? xcd * (q + 1) : r * (q + 1) + (xcd - r) * q) + off; }
        const int nig = WGM * nN, gid = wgid / nig, fm = gid * WGM, gsz = (nM - fm) < WGM ? (nM - fm) : WGM;
        u.pm = fm + ((wgid % nig) % gsz); u.pn = (wgid % nig) / gsz; return true;
    }
};

struct EpiProj {
    static constexpr bool PERM = true, AFTER_DRAIN = false;
    bf16_t* O; int ldc; const float* rs;
    __device__ __forceinline__ void operator()(const f32x4 (&acc)[2][2][4][2], const Unit& u, int wr, int wc, int fr, int fq) const {
        const int row0 = u.pm * BM + wr * 64 + fr, col0 = u.pn * BM + wc * 32 + 8 * fq;
#pragma unroll
        for (int ai = 0; ai < 2; ++ai)
#pragma unroll
            for (int m = 0; m < 4; ++m) { const int r = row0 + ai * HALF + m * 16; const float s = rs[r]; bf16_t* rowp = O + (size_t)r * ldc + col0;
#pragma unroll
                for (int bj = 0; bj < 2; ++bj) { const f32x4 v0 = acc[ai][bj][m][0] * s, v1 = acc[ai][bj][m][1] * s;
                    u32x4 w; w.x = pk2(v0[0], v0[1]); w.y = pk2(v0[2], v0[3]); w.z = pk2(v1[0], v1[1]); w.w = pk2(v1[2], v1[3]);
                    *(u32x4*)(rowp + bj * HALF) = w; } }
    }
};
struct EpiSwiglu {
    static constexpr bool PERM = true, AFTER_DRAIN = false;
    bf16_t* O; int ldc; const float* ss;
    __device__ __forceinline__ void operator()(const f32x4 (&acc)[2][2][4][2], const Unit& u, int wr, int wc, int fr, int fq) const {
        const int row0 = u.pm * BM + wr * 64 + fr, col0 = u.pn * HALF + wc * 32 + 8 * fq;
#pragma unroll
        for (int ai = 0; ai < 2; ++ai)
#pragma unroll
            for (int m = 0; m < 4; ++m) { const int r = row0 + ai * HALF + m * 16;
                const f32x4 p0 = *(const f32x4*)(ss + (size_t)r * 8), p1 = *(const f32x4*)(ss + (size_t)r * 8 + 4);
                const float tot = ((p0[0] + p0[1]) + (p0[2] + p0[3])) + ((p1[0] + p1[1]) + (p1[2] + p1[3]));
                const float s = __builtin_amdgcn_rsqf(tot * (1.0f / D_) + EPS);
                float o[8];
#pragma unroll
                for (int n = 0; n < 2; ++n)
#pragma unroll
                    for (int j = 0; j < 4; ++j) { const float g = acc[ai][0][m][n][j] * s, up = acc[ai][1][m][n][j] * s; o[n * 4 + j] = g * sigm(g) * up; }
                u32x4 w; w.x = pk2(o[0], o[1]); w.y = pk2(o[2], o[3]); w.z = pk2(o[4], o[5]); w.w = pk2(o[6], o[7]);
                *(u32x4*)(O + (size_t)r * ldc + col0) = w; }
    }
};
struct EpiNull { static constexpr bool PERM = true, AFTER_DRAIN = false; float* sink;
    __device__ __forceinline__ void operator()(const f32x4 (&acc)[2][2][4][2], const Unit& u, int wr, int wc, int fr, int fq) const { if (acc[0][0][0][0][0] == 123.456f) sink[0] = 1.f; } };
struct EpiResid {
    static constexpr bool PERM = true, AFTER_DRAIN = true;
    const bf16_t* base; float* out; bf16_t* ob; int ldc; float* ss;
    __device__ __forceinline__ void fused(f32x4 (&acc)[2][2][4][2], const Unit& u, int wr, int wc, int fr, int fq, LAS unsigned char* lds, int wid, int lane) const {
        LAS float* P = (LAS float*)lds;
        const int col0 = u.pn * BM + wc * 32 + 8 * fq;
#pragma unroll
        for (int ai = 0; ai < 2; ++ai)
#pragma unroll
            for (int m = 0; m < 4; ++m) { const int rl = ai * HALF + wr * 64 + m * 16 + fr; const size_t off = (size_t)(u.pm * BM + rl) * ldc + col0; float q = 0.f;
#pragma unroll
                for (int bj = 0; bj < 2; ++bj) {
                    const u32x4 bw = __builtin_nontemporal_load((const u32x4*)(base + off + bj * HALF));
                    const f32x4 b0 = (f32x4){bf_lo(bw.x), bf_hi(bw.x), bf_lo(bw.y), bf_hi(bw.y)}, b1 = (f32x4){bf_lo(bw.z), bf_hi(bw.z), bf_lo(bw.w), bf_hi(bw.w)};
                    const f32x4 v0 = acc[ai][bj][m][0] + b0, v1 = acc[ai][bj][m][1] + b1;
                    if (out) { *(f32x4*)(out + off + bj * HALF) = v0; *(f32x4*)(out + off + bj * HALF + 4) = v1; }
                    if (ob) { u32x4 w; w.x = pk2(v0[0], v0[1]); w.y = pk2(v0[2], v0[3]); w.z = pk2(v1[0], v1[1]); w.w = pk2(v1[2], v1[3]); *(u32x4*)(ob + off + bj * HALF) = w; }
                    q += (v0[0] * v0[0] + v0[1] * v0[1]) + (v0[2] * v0[2] + v0[3] * v0[3]) + (v1[0] * v1[0] + v1[1] * v1[1]) + (v1[2] * v1[2] + v1[3] * v1[3]); }
                q += __shfl_xor(q, 16); q += __shfl_xor(q, 32);
                if (fq == 0) P[rl * 4 + wc] = q;
                if (m & 1) asm volatile("" ::: "memory"); }
        __syncthreads();
        const int t = wid * 64 + lane;
        if (t < 256) { const f32x4 p = *(const LAS f32x4*)(P + t * 4); ss[(size_t)(u.pm * BM + t) * 8 + u.pn] = (p[0] + p[1]) + (p[2] + p[3]); }
        __syncthreads();
    }
};

struct EpiFinal {
    static constexpr bool PERM = true, AFTER_DRAIN = true;
    const bf16_t* base; float* out; int ldc; float* ss; unsigned* cnt; const float* w; unsigned* tmo;
    __device__ __forceinline__ void fused(f32x4 (&acc)[2][2][4][2], const Unit& u, int wr, int wc, int fr, int fq, LAS unsigned char* lds, int wid, int lane) const {
        LAS float* P = (LAS float*)lds;
        LAS float* R = (LAS float*)(lds + 4096);
        const int col0 = u.pn * BM + wc * 32 + 8 * fq;
#pragma unroll
        for (int ai = 0; ai < 2; ++ai)
#pragma unroll
            for (int m = 0; m < 4; ++m) { const int rl = ai * HALF + wr * 64 + m * 16 + fr; const size_t off = (size_t)(u.pm * BM + rl) * ldc + col0; float q = 0.f;
#pragma unroll
                for (int bj = 0; bj < 2; ++bj) {
                    const u32x4 bw = __builtin_nontemporal_load((const u32x4*)(base + off + bj * HALF));
                    const f32x4 b0 = (f32x4){bf_lo(bw.x), bf_hi(bw.x), bf_lo(bw.y), bf_hi(bw.y)}, b1 = (f32x4){bf_lo(bw.z), bf_hi(bw.z), bf_lo(bw.w), bf_hi(bw.w)};
                    const f32x4 v0 = acc[ai][bj][m][0] + b0, v1 = acc[ai][bj][m][1] + b1;
                    acc[ai][bj][m][0] = v0; acc[ai][bj][m][1] = v1;
                    q += (v0[0] * v0[0] + v0[1] * v0[1]) + (v0[2] * v0[2] + v0[3] * v0[3]) + (v1[0] * v1[0] + v1[1] * v1[1]) + (v1[2] * v1[2] + v1[3] * v1[3]); }
                q += __shfl_xor(q, 16); q += __shfl_xor(q, 32);
                if (fq == 0) P[rl * 4 + wc] = q;
                if (m & 1) asm volatile("" ::: "memory"); }
        __syncthreads();
        const int t = wid * 64 + lane;
        unsigned* pc = cnt + 64 * u.pm;
        if (t < 256) { const f32x4 p = *(const LAS f32x4*)(P + t * 4);
            __hip_atomic_store(ss + (size_t)(u.pm * BM + t) * 8 + u.pn, (p[0] + p[1]) + (p[2] + p[3]), __ATOMIC_RELAXED, __HIP_MEMORY_SCOPE_AGENT);
            asm volatile("s_waitcnt vmcnt(0)" ::: "memory");
            if (lane == 0) __hip_atomic_fetch_add(pc, 1u, __ATOMIC_RELAXED, __HIP_MEMORY_SCOPE_AGENT); }
        if (wid == 0) {
            unsigned sp = 0;
            while ((unsigned)__builtin_amdgcn_readfirstlane(__hip_atomic_load(pc, __ATOMIC_RELAXED, __HIP_MEMORY_SCOPE_AGENT)) < 32u) {
                __builtin_amdgcn_s_sleep(2);
                if (++sp > (1u << 22)) { if (lane == 0) __hip_atomic_store(tmo, 1u, __ATOMIC_RELAXED, __HIP_MEMORY_SCOPE_AGENT); break; } }
            __builtin_amdgcn_fence(__ATOMIC_ACQUIRE, "agent");
            asm volatile("s_waitcnt vmcnt(0)" ::: "memory");
        }
        __syncthreads();
        if (t < 256) { const float* sp8 = ss + (size_t)(u.pm * BM + t) * 8; float tot = 0.f;
#pragma unroll
            for (int j = 0; j < 8; ++j) tot += __hip_atomic_load(sp8 + j, __ATOMIC_RELAXED, __HIP_MEMORY_SCOPE_AGENT);
            R[t] = 1.0f / sqrtf(tot * (1.0f / D_) + EPS); }
        __syncthreads();
        f32x4 wv[2][2];
#pragma unroll
        for (int bj = 0; bj < 2; ++bj) { wv[bj][0] = *(const f32x4*)(w + col0 + bj * HALF); wv[bj][1] = *(const f32x4*)(w + col0 + bj * HALF + 4); }
#pragma unroll
        for (int ai = 0; ai < 2; ++ai)
#pragma unroll
            for (int m = 0; m < 4; ++m) { const int rl = ai * HALF + wr * 64 + m * 16 + fr; const size_t off = (size_t)(u.pm * BM + rl) * ldc + col0; const float rs = R[rl];
#pragma unroll
                for (int bj = 0; bj < 2; ++bj) { *(f32x4*)(out + off + bj * HALF) = acc[ai][bj][m][0] * rs * wv[bj][0]; *(f32x4*)(out + off + bj * HALF + 4) = acc[ai][bj][m][1] * rs * wv[bj][1]; } }
        __syncthreads();
    }
};

template <class Epi, class Sched, bool ALIGN_EPI = false, bool SP2 = false>
__device__ __forceinline__ void gemm_phase(LAS unsigned char* lds, const Gemm g, const Sched& S, const Epi& E) {
    const int tid = threadIdx.x, wid = __builtin_amdgcn_readfirstlane(tid >> 6), lane = tid & 63, wr = wid >> 2, wc = wid & 3, fr = lane & 15, fq = lane >> 4;
    const int K = g.K, nt = K / BK;
    unsigned voffA[2], voffB[2];
#pragma unroll
    for (int i = 0; i < 2; ++i) { int R, C; stage_rc(tid * 16 + i * 8192, R, C); const int Rb = Epi::PERM ? ((R & ~31) + perm32(R & 31)) : R;
        voffA[i] = (unsigned)(R * K + C) * 2u; voffB[i] = (unsigned)(Rb * K + C) * 2u; }
    const size_t kstep = (size_t)(BK * 2);
    const size_t hstep = (size_t)HALF * K * 2;
    const size_t tstep = 2 * hstep;
    const unsigned ldsw = (unsigned)wid * 1024u;
    const int aoff = lds_byte(wr * 64 + fr, fq * 8), boff = lds_byte(wc * 32 + fr, fq * 8);
#define PG8_SA(b, h) (((b) * 2 + (h)) * HTB)
#define PG8_SB(b, h) ((4 + (b) * 2 + (h)) * HTB)
#define PG8_STAGE(bufoff, gbase, voff) do { _Pragma("unroll") for (int _i = 0; _i < 2; ++_i) \
        __builtin_amdgcn_global_load_lds((const unsigned*)((const char*)(gbase) + (voff)[_i]), (LAS unsigned*)(lds + (bufoff) + ldsw + _i * 8192), 16, 0, 0); } while (0)
#define PG8_LDA(dst, b, h) do { _Pragma("unroll") for (int m = 0; m < 4; ++m) _Pragma("unroll") for (int k = 0; k < 2; ++k) dst[m][k] = *(const LAS bf16x8*)(lds + PG8_SA(b, h) + aoff + m * 2048 + k * 1024); } while (0)
#define PG8_LDB(dst, b, h) do { _Pragma("unroll") for (int n = 0; n < 2; ++n) _Pragma("unroll") for (int k = 0; k < 2; ++k) dst[n][k] = *(const LAS bf16x8*)(lds + PG8_SB(b, h) + boff + n * 2048 + k * 1024); } while (0)
#define PG8_MMA(ai, bj, At, Bt) do { __builtin_amdgcn_s_setprio(1); _Pragma("unroll") for (int m = 0; m < 4; ++m) _Pragma("unroll") for (int n = 0; n < 2; ++n) _Pragma("unroll") for (int k = 0; k < 2; ++k) \
        acc[ai][bj][m][n] = __builtin_amdgcn_mfma_f32_16x16x32_bf16(Bt[n][k], At[m][k], acc[ai][bj][m][n], 0, 0, 0); __builtin_amdgcn_s_setprio(0); } while (0)
#define PG8_WAIT_V(n) asm volatile("s_waitcnt vmcnt(" #n ")" ::: "memory")
#define PG8_WAIT_L(n) asm volatile("s_waitcnt lgkmcnt(" #n ")" ::: "memory")
#define PG8_BAR __builtin_amdgcn_s_barrier()
#define PG8_SCHED __builtin_amdgcn_sched_barrier(0)
    Unit cur, nxt; int ui = 0;
    if (!S.next(0, cur)) return;
    f32x4 acc[2][2][4][2];
#pragma unroll
    for (int a = 0; a < 2; ++a)
#pragma unroll
        for (int b = 0; b < 2; ++b)
#pragma unroll
            for (int m = 0; m < 4; ++m)
#pragma unroll
                for (int n = 0; n < 2; ++n) acc[a][b][m][n] = (f32x4){0.f, 0.f, 0.f, 0.f};
    bf16x8 At[4][2], B0[2][2], B1[2][2];
    const char* cA = (const char*)g.A + (size_t)cur.pm * tstep; const char* cB = (const char*)g.Bt + (size_t)cur.pn * tstep;
    if constexpr (SP2) {
        PG8_STAGE(PG8_SB(0, 0), cB, voffB); PG8_STAGE(PG8_SB(0, 1), cB + hstep, voffB); PG8_STAGE(PG8_SA(0, 0), cA, voffA); PG8_STAGE(PG8_SA(0, 1), cA + hstep, voffA);
        if (wr == 1) PG8_BAR;
        PG8_WAIT_V(2); PG8_BAR;
        PG8_STAGE(PG8_SB(1, 0), cB + kstep, voffB); PG8_STAGE(PG8_SA(1, 0), cA + kstep, voffA); PG8_STAGE(PG8_SB(1, 1), cB + hstep + kstep, voffB);
        PG8_WAIT_V(6); PG8_BAR;
    } else {
        PG8_STAGE(PG8_SB(0, 0), cB, voffB); PG8_STAGE(PG8_SA(0, 0), cA, voffA); PG8_STAGE(PG8_SB(0, 1), cB + hstep, voffB); PG8_STAGE(PG8_SA(0, 1), cA + hstep, voffA);
        if (wr == 1) PG8_BAR;
        PG8_WAIT_V(4); PG8_BAR;
        PG8_STAGE(PG8_SB(1, 0), cB + kstep, voffB); PG8_STAGE(PG8_SA(1, 0), cA + kstep, voffA); PG8_STAGE(PG8_SB(1, 1), cB + hstep + kstep, voffB);
        PG8_WAIT_V(6); PG8_BAR;
    }
    for (;;) {
        const bool has_next = S.next(ui + 1, nxt);
        const char* nA = has_next ? (const char*)g.A + (size_t)nxt.pm * tstep : cA; const char* nB = has_next ? (const char*)g.Bt + (size_t)nxt.pn * tstep : cB;
        for (int t = 0; t < nt; t += 2) {
            const bool last = (t == nt - 2);
            const char* a1 = cA + (size_t)(t + 1) * kstep;
            const char* a2 = last ? nA : cA + (size_t)(t + 2) * kstep; const char* b2 = last ? nB : cB + (size_t)(t + 2) * kstep;
            const char* a3 = a2 + kstep; const char* b3 = b2 + kstep;
            if constexpr (SP2) {
            PG8_LDB(B0, 0, 0); PG8_LDB(B1, 0, 1); PG8_SCHED; PG8_LDA(At, 0, 0); PG8_STAGE(PG8_SA(1, 1), a1 + hstep, voffA);
            PG8_WAIT_V(8); PG8_WAIT_L(0); PG8_BAR; PG8_MMA(0, 0, At, B0); PG8_MMA(0, 1, At, B1); PG8_BAR; PG8_SCHED;
            PG8_LDA(At, 0, 1); PG8_STAGE(PG8_SB(0, 0), b2, voffB); PG8_STAGE(PG8_SB(0, 1), b2 + hstep, voffB); PG8_STAGE(PG8_SA(0, 0), a2, voffA);
            PG8_WAIT_V(8); PG8_WAIT_L(0); PG8_BAR; PG8_MMA(1, 0, At, B0); PG8_MMA(1, 1, At, B1); PG8_BAR; PG8_SCHED;
            PG8_LDB(B0, 1, 0); PG8_LDB(B1, 1, 1); PG8_SCHED; PG8_LDA(At, 1, 0); PG8_STAGE(PG8_SA(0, 1), a2 + hstep, voffA);
            PG8_WAIT_V(8); PG8_WAIT_L(0); PG8_BAR; PG8_MMA(0, 0, At, B0); PG8_MMA(0, 1, At, B1); PG8_BAR; PG8_SCHED;
            PG8_LDA(At, 1, 1); PG8_STAGE(PG8_SB(1, 0), b3, voffB); PG8_STAGE(PG8_SB(1, 1), b3 + hstep, voffB); PG8_STAGE(PG8_SA(1, 0), a3, voffA);
            PG8_WAIT_V(8); PG8_WAIT_L(0); PG8_BAR; PG8_MMA(1, 0, At, B0); PG8_MMA(1, 1, At, B1); PG8_BAR; PG8_SCHED;
            } else {
            PG8_LDB(B0, 0, 0); PG8_SCHED; PG8_LDA(At, 0, 0); PG8_STAGE(PG8_SA(1, 1), a1 + hstep, voffA);
            PG8_WAIT_L(8); PG8_BAR; PG8_WAIT_L(0); PG8_MMA(0, 0, At, B0); PG8_BAR; PG8_SCHED;
            PG8_LDB(B1, 0, 1); PG8_STAGE(PG8_SB(0, 0), b2, voffB);
            PG8_BAR; PG8_WAIT_L(0); PG8_MMA(0, 1, At, B1); PG8_BAR;
            PG8_LDA(At, 0, 1); PG8_STAGE(PG8_SA(0, 0), a2, voffA);
            PG8_BAR; PG8_WAIT_L(0); PG8_MMA(1, 0, At, B0); PG8_BAR; PG8_SCHED;
            PG8_STAGE(PG8_SB(0, 1), b2 + hstep, voffB);
            PG8_WAIT_V(6); PG8_BAR; PG8_MMA(1, 1, At, B1); PG8_BAR;
            PG8_LDB(B0, 1, 0); PG8_SCHED; PG8_LDA(At, 1, 0); PG8_STAGE(PG8_SA(0, 1), a2 + hstep, voffA);
            PG8_WAIT_L(8); PG8_BAR; PG8_WAIT_L(0); PG8_MMA(0, 0, At, B0); PG8_BAR; PG8_SCHED;
            PG8_LDB(B1, 1, 1); PG8_STAGE(PG8_SB(1, 0), b3, voffB);
            PG8_BAR; PG8_WAIT_L(0); PG8_MMA(0, 1, At, B1); PG8_BAR;
            PG8_LDA(At, 1, 1); PG8_STAGE(PG8_SA(1, 0), a3, voffA);
            PG8_BAR; PG8_WAIT_L(0); PG8_MMA(1, 0, At, B0); PG8_BAR; PG8_SCHED;
            PG8_STAGE(PG8_SB(1, 1), b3 + hstep, voffB);
            PG8_WAIT_V(6); PG8_BAR; PG8_MMA(1, 1, At, B1); PG8_BAR;
            }
        }
        if constexpr (ALIGN_EPI) { if (wr == 0) PG8_BAR; }
        if constexpr (!Epi::AFTER_DRAIN) { E(acc, cur, wr, wc, fr, fq); }
        if (!has_next) break;
#pragma unroll
        for (int a = 0; a < 2; ++a)
#pragma unroll
            for (int b = 0; b < 2; ++b)
#pragma unroll
                for (int m = 0; m < 4; ++m)
#pragma unroll
                    for (int n = 0; n < 2; ++n) acc[a][b][m][n] = (f32x4){0.f, 0.f, 0.f, 0.f};
        cur = nxt; cA = nA; cB = nB; ++ui;
        if constexpr (ALIGN_EPI) { if (wr == 1) PG8_BAR; }
    }
    PG8_WAIT_V(0);
    if constexpr (!ALIGN_EPI) { if (wr == 0) PG8_BAR; }
    PG8_BAR;
    if constexpr (Epi::AFTER_DRAIN) { E.fused(acc, cur, wr, wc, fr, fq, lds, wid, lane); }
#undef PG8_SA
#undef PG8_SB
#undef PG8_STAGE
#undef PG8_LDA
#undef PG8_LDB
#undef PG8_MMA
#undef PG8_WAIT_V
#undef PG8_WAIT_L
#undef PG8_BAR
#undef PG8_SCHED
}
}


#define XB_TMO      128
#define XB_XCNT(j)  (256  + 64 * (j))
#define XB_XSUB(j)  (1280 + 64 * (j))
#define XB_XGEN(j)  (2304 + 64 * (j))
#define XB_TOP      3328
#define XB_TOPGEN   3392
#define XCD_BAR_WORDS 3456
#define XB_SPIN_CAP (1u << 22)
__device__ __forceinline__ unsigned xb_ld(unsigned* p)              { return __hip_atomic_load(p, __ATOMIC_RELAXED, __HIP_MEMORY_SCOPE_AGENT); }
__device__ __forceinline__ unsigned xb_add(unsigned* p, unsigned v) { return __hip_atomic_fetch_add(p, v, __ATOMIC_RELAXED, __HIP_MEMORY_SCOPE_AGENT); }
__device__ __forceinline__ unsigned xb_xcc_id() { return (unsigned)__builtin_amdgcn_s_getreg((3 << 11) | 20) & 0xFu; }
#define XB_SPIN(cond, bar) do { unsigned _sp = 0; while (cond) { __builtin_amdgcn_s_sleep(1); \
    if ((++_sp & 255u) == 0u) { if (xb_ld(&(bar)[XB_TMO])) break; if (_sp > XB_SPIN_CAP) { atomicAdd(&(bar)[XB_TMO], 1u); break; } } } } while (0)
struct XcdBarrier { unsigned* bar; unsigned x; volatile LAS unsigned* st; };
__device__ __forceinline__ XcdBarrier xcd_barrier_post(unsigned* bar, volatile LAS unsigned* st) {
    XcdBarrier b; b.bar = bar; b.x = xb_xcc_id(); b.st = st;
    if (threadIdx.x == 0) (void)xb_add(&bar[XB_XCNT(b.x)], 1u);
    return b;
}
__device__ __forceinline__ void xcd_barrier_complete(unsigned* bar, unsigned x, unsigned& nloc, unsigned& nx) {
    const unsigned G = gridDim.x * gridDim.y * gridDim.z;
    unsigned sum, cnt, mine, sp = 0u;
    for (;;) {
        sum = 0u; cnt = 0u; mine = 0u;
#pragma unroll
        for (unsigned j = 0; j < 16; ++j) { const unsigned c = xb_ld(&bar[XB_XCNT(j)]); sum += c; cnt += (c > 0u) ? 1u : 0u; mine = (j == x) ? c : mine; }
        if (sum == G) break;
        __builtin_amdgcn_s_sleep(1);
        if ((++sp & 255u) == 0u) { if (xb_ld(&bar[XB_TMO])) break; if (sp > XB_SPIN_CAP) { atomicAdd(&bar[XB_TMO], 1u); break; } }
    }
    nloc = mine > 0u ? mine : 1u; nx = cnt > 0u ? cnt : 1u;
}
__device__ __forceinline__ void xcd_barrier(const XcdBarrier& b) {
    asm volatile("s_waitcnt vmcnt(0)" ::: "memory");
    __syncthreads();
    if (threadIdx.x == 0) {
        unsigned* bar = b.bar;
        __builtin_amdgcn_s_waitcnt(0);
        unsigned nloc = b.st[0], nx = b.st[1];
        if (nloc == 0u) { xcd_barrier_complete(bar, b.x, nloc, nx); b.st[0] = nloc; b.st[1] = nx; }
        const unsigned old = xb_add(&bar[XB_XSUB(b.x)], 1u);
        const unsigned gen = old / nloc;
        if (old + 1u == (gen + 1u) * nloc) {
            __builtin_amdgcn_fence(__ATOMIC_RELEASE, "agent");
            asm volatile("s_waitcnt vmcnt(0)" ::: "memory");
            const unsigned og = xb_add(&bar[XB_TOP], 1u);
            const unsigned tg = og / nx;
            if (og + 1u == (tg + 1u) * nx) xb_add(&bar[XB_TOPGEN], 1u);
            else XB_SPIN(xb_ld(&bar[XB_TOPGEN]) == tg, bar);
            __builtin_amdgcn_fence(__ATOMIC_ACQUIRE, "agent");
            xb_add(&bar[XB_XGEN(b.x)], 1u);
            asm volatile("s_waitcnt vmcnt(0)" ::: "memory");
        } else {
            XB_SPIN(xb_ld(&bar[XB_XGEN(b.x)]) == gen, bar);
            __builtin_amdgcn_fence(__ATOMIC_ACQUIRE, "agent");
            asm volatile("s_waitcnt vmcnt(0)" ::: "memory");
        }
    }
    __syncthreads();
}

struct Args { const float* in[17]; float* out; unsigned char* ws; int ph_lo, ph_hi; };
struct Ctx {
    LAS unsigned char* lds; int tid, lane, wave, G, bid;
    const float *x, *ln1, *w_in, *conv_w, *conv_b, *ga_w, *ga_b, *gx_w, *gx_b, *lam, *gn_w, *w_out, *ln2, *w_g, *w_u, *w_d, *fnw;
    float* out; unsigned char* ws;
};

struct TDesc { const float* W; bf16_t* WT; const float* ks; int K, N, mode, item; };
__device__ __forceinline__ void t_load(const TDesc& d, int lane, float (&v)[32], f32x4& s0, f32x4& s1) {
    const int nblk = d.N >> 5, kb = d.item / nblk, nb = d.item - kb * nblk, k0 = 64 * kb, n0 = 32 * nb;
    const float* p = d.W + (size_t)(k0 + (lane >> 5)) * d.N + n0 + (lane & 31);
    const size_t rs2 = (size_t)2 * d.N;
#pragma unroll
    for (int i = 0; i < 32; ++i) v[i] = __builtin_nontemporal_load(p + i * rs2);
    s0 = (f32x4){1.f, 1.f, 1.f, 1.f}; s1 = s0;
    if (d.ks) { const float* kp = d.ks + k0 + 8 * (lane & 7); s0 = *(const f32x4*)kp; s1 = *(const f32x4*)(kp + 4); }
}
__device__ __forceinline__ void t_store(const TDesc& d, int lane, const float (&v)[32], const f32x4 s0, const f32x4 s1, LAS float* scr) {
    const int nblk = d.N >> 5, kb = d.item / nblk, nb = d.item - kb * nblk, k0 = 64 * kb, n0 = 32 * nb;
#pragma unroll
    for (int i = 0; i < 32; ++i) { const int kk = 2 * i + (lane >> 5); scr[kk * 33 + (lane & 31)] = v[i]; }
    asm volatile("s_waitcnt lgkmcnt(0)" ::: "memory");
    const int c = lane & 7;
#pragma unroll
    for (int j = 0; j < 4; ++j) { const int n = (lane >> 3) + 8 * j; const LAS float* s = scr + (8 * c) * 33 + n;
        u32x4 o; o.x = pk2(s[0 * 33] * s0[0], s[1 * 33] * s0[1]); o.y = pk2(s[2 * 33] * s0[2], s[3 * 33] * s0[3]); o.z = pk2(s[4 * 33] * s1[0], s[5 * 33] * s1[1]); o.w = pk2(s[6 * 33] * s1[2], s[7 * 33] * s1[3]);
        const int ng = n0 + n;
        int drow = ng;
        if (d.mode == 1) drow = (ng >> 7) * 256 + (ng & 127);
        else if (d.mode == 2) drow = (ng >> 7) * 256 + 128 + (ng & 127);
        *(u32x4*)(d.WT + (size_t)drow * d.K + k0 + 8 * c) = o; }
    asm volatile("s_waitcnt lgkmcnt(0)" ::: "memory");
}
__device__ __forceinline__ bool p0_desc(const Ctx& F, int part, int it, TDesc& d) {
    constexpr int I_IN = (D_ / 64) * (DIN / 32), I_OUT = (D_ / 64) * (D_ / 32), I_G = (D_ / 64) * (DFF / 32), I_D = (DFF / 64) * (D_ / 32), I_LG = 8 * 2 * 4;
    d.ks = nullptr; d.mode = 0;
    if (part == 0) {
        if (it >= I_IN + 2 * I_LG) return false;
        int r = it;
        if (r < I_IN) { d.W = F.w_in; d.WT = (bf16_t*)(F.ws + WS_WIN); d.ks = F.ln1; d.K = D_; d.N = DIN; d.item = r; return true; } r -= I_IN;
        const bool isx = r >= I_LG; if (isx) r -= I_LG;
        const int blk = r >> 3;
        d.W = (isx ? F.gx_w : F.ga_w) + (size_t)blk * 16384; d.WT = (bf16_t*)(F.ws + (isx ? WS_GXT : WS_GAT)) + (size_t)blk * 16384; d.K = 128; d.N = 128; d.item = r & 7; return true;
    } else if (part == 1) {
        if (it >= I_OUT + 2 * I_G) return false;
        int r = it;
        if (r < I_OUT) { d.W = F.w_out; d.WT = (bf16_t*)(F.ws + WS_WOUT); d.K = D_; d.N = D_; d.item = r; return true; } r -= I_OUT;
        const bool isu = r >= I_G; if (isu) r -= I_G;
        d.W = isu ? F.w_u : F.w_g; d.WT = (bf16_t*)(F.ws + WS_WGU); d.ks = F.ln2; d.K = D_; d.N = DFF; d.mode = isu ? 2 : 1; d.item = r; return true;
    }
    if (it >= I_D) return false;
    d.W = F.w_d; d.WT = (bf16_t*)(F.ws + WS_WD); d.K = DFF; d.N = D_; d.item = it; return true;
}
__device__ __forceinline__ void x_load(const Ctx& F, int m, f32x4 (&v)[8]) {
    const f32x4* xr = (const f32x4*)(F.x + (size_t)m * D_) + F.lane;
#pragma unroll
    for (int j = 0; j < 8; ++j) v[j] = __builtin_nontemporal_load(xr + 64 * j);
}
__device__ __forceinline__ void x_store(const Ctx& F, int m, const f32x4 (&v)[8]) {
    float s = 0.f;
#pragma unroll
    for (int j = 0; j < 8; ++j) s += (v[j][0] * v[j][0] + v[j][1] * v[j][1]) + (v[j][2] * v[j][2] + v[j][3] * v[j][3]);
    s = wave_sum(s);
    if (F.lane == 0) ((float*)(F.ws + WS_RSTD1))[m] = 1.0f / sqrtf(s * (1.0f / D_) + EPS);
    u32x2* o8 = (u32x2*)((bf16_t*)F.out + (size_t)m * D_) + F.lane;
#pragma unroll
    for (int j = 0; j < 8; ++j) { u32x2 w; w.x = pk2(v[j][0], v[j][1]); w.y = pk2(v[j][2], v[j][3]); o8[64 * j] = w; }
}
__device__ __forceinline__ void p0_prologue(Ctx& F, int part, int gw, int NGW) {
    LAS float* scr = (LAS float*)(F.lds + F.wave * 8704);
    {
        TDesc dA, dB; float vA[32], vB[32]; f32x4 a0, a1, b0, b1;
        int it = gw;
        bool hA = p0_desc(F, part, it, dA);
        if (hA) t_load(dA, F.lane, vA, a0, a1);
        while (hA) {
            const bool hB = p0_desc(F, part, it + NGW, dB);
            if (hB) t_load(dB, F.lane, vB, b0, b1);
            t_store(dA, F.lane, vA, a0, a1, scr);
            if (!hB) break;
            hA = p0_desc(F, part, it + 2 * NGW, dA);
            if (hA) t_load(dA, F.lane, vA, a0, a1);
            t_store(dB, F.lane, vB, b0, b1, scr);
            it += 2 * NGW;
        }
    }
    if (part != 0) return;
    {
        f32x4 vA[8], vB[8];
        int m = gw;
        if (m < S_) x_load(F, m, vA);
        while (m < S_) {
            const int mb = m + NGW;
            if (mb < S_) x_load(F, mb, vB);
            x_store(F, m, vA);
            if (mb >= S_) break;
            m = mb + NGW;
            if (m < S_) x_load(F, m, vA);
            x_store(F, mb, vB);
        }
    }
}

template <bool FINAL>
__device__ __forceinline__ void p2_lru(Ctx& F, int cpart, int cbase, int cstep, int cslots) {
    const bf16_t* proj = (const bf16_t*)(F.ws + WS_PROJ);
    const bf16_t* GaT = (const bf16_t*)(F.ws + WS_GAT); const bf16_t* GxT = (const bf16_t*)(F.ws + WS_GXT);
    float* Atot = (float*)(F.ws + WS_ATOT); float* Hend = (float*)(F.ws + WS_HEND);
    const float* carry = (const float*)(F.ws + WS_CARRY); bf16_t* Y = (bf16_t*)(F.ws + WS_Y);
    LAS float* XC = (LAS float*)F.lds;
    LAS float* HB = (LAS float*)(F.lds + 33792);
    LAS bf16_t* HL = (LAS bf16_t*)(F.lds + 33792); LAS bf16_t* PL = (LAS bf16_t*)(F.lds + 51200);
    bf16_t* hlocB = (bf16_t*)F.out + (size_t)S_ * D_; bf16_t* pcumB = hlocB + (size_t)S_ * DLRU;
    const int w = F.wave, lane = F.lane, r16 = lane & 15, g4 = lane >> 4;
    int curn = -1; bf16x8 Ba[4], Bx[4]; float bar = 0.f, bxr = 0.f, kch = 0.f;
    float cw0[4] = {0.f, 0.f, 0.f, 0.f}, cw1[4] = {0.f, 0.f, 0.f, 0.f}; f32x2 cb = (f32x2){0.f, 0.f};
    unsigned xn[11];
    { const int it0 = F.bid; const int n0 = it0 & 7, tb = (it0 >> 3) * LCH + w * 8 - 3;
#pragma unroll
      for (int i = 0; i < 11; ++i) { const int t = tb + i; xn[i] = 0u; if (it0 < NLCH * 8 && t >= 0) xn[i] = __builtin_nontemporal_load((const unsigned*)(proj + (size_t)t * DIN + n0 * 128 + 2 * lane)); } }
    LAS float* cscr = (LAS float*)(F.lds + 69632 + w * 8704);
    int slot = 0;
    for (int it = F.bid; it < NLCH * 8; it += F.G, ++slot) {
        const int n = it & 7, chunk = it >> 3, t0 = chunk * LCH;
        const int chl = 16 * w + r16, ch = n * 128 + chl;
        TDesc cd; float cv[32]; f32x4 cs0, cs1;
        const bool hc = (slot < cslots) && p0_desc(F, cpart, cbase + slot * cstep, cd);
        if (n != curn) { curn = n;
#pragma unroll
            for (int kk = 0; kk < 4; ++kk) { Ba[kk] = *(const bf16x8*)(GaT + ((size_t)n * 128 + chl) * 128 + 32 * kk + 8 * g4); Bx[kk] = *(const bf16x8*)(GxT + ((size_t)n * 128 + chl) * 128 + 32 * kk + 8 * g4); }
            bar = F.ga_b[ch]; bxr = F.gx_b[ch];
            const float lm = F.lam[ch]; const float logsig = -log1pf(expf(-lm));
            kch = 8.0f * logsig;
#pragma unroll
            for (int k = 0; k < 4; ++k) { const f32x2 c2 = *(const f32x2*)(F.conv_w + k * DLRU + n * 128 + 2 * lane); cw0[k] = c2[0]; cw1[k] = c2[1]; }
            cb = *(const f32x2*)(F.conv_b + n * 128 + 2 * lane);
        }
        const int etok = F.tid >> 3, ec16 = (F.tid & 7) * 16;
        u32x4 gq0 = (u32x4){0u, 0u, 0u, 0u}, gq1 = gq0; float Hc = 0.f;
        if constexpr (FINAL) { const bf16_t* gp = proj + (size_t)(t0 + etok) * DIN + DLRU + n * 128 + ec16; gq0 = *(const u32x4*)gp; gq1 = *(const u32x4*)(gp + 8); Hc = carry[chunk * DLRU + ch]; }
        { const int cp = lane, tg = w;
          float xw0[11], xw1[11];
#pragma unroll
          for (int i = 0; i < 11; ++i) { xw0[i] = bf_lo(xn[i]); xw1[i] = bf_hi(xn[i]); }
#pragma unroll
          for (int j = 0; j < 8; ++j) { float y0 = cb[0], y1 = cb[1];
#pragma unroll
              for (int k = 0; k < 4; ++k) { y0 += cw0[k] * xw0[j + k]; y1 += cw1[k] * xw1[j + k]; }
              *(LAS f32x2*)(XC + (tg * 8 + j) * 132 + 2 * cp) = (f32x2){y0, y1}; }
        }
        __syncthreads();
        { const int itn = it + F.G; const int nn = itn & 7, tb = (itn >> 3) * LCH + w * 8 - 3;
          if (itn < NLCH * 8) {
#pragma unroll
            for (int i = 0; i < 11; ++i) xn[i] = __builtin_nontemporal_load((const unsigned*)(proj + (size_t)(tb + i) * DIN + nn * 128 + 2 * lane)); } }
        if (hc) t_load(cd, lane, cv, cs0, cs1);
        float Pc = 1.f;
#pragma unroll
        for (int m = 0; m < 4; ++m) {
            f32x4 ar = (f32x4){0.f, 0.f, 0.f, 0.f}, ax = (f32x4){0.f, 0.f, 0.f, 0.f};
#pragma unroll
            for (int kk = 0; kk < 4; ++kk) { const LAS float* xr = XC + (16 * m + r16) * 132 + 32 * kk + 8 * g4;
                const f32x4 x0 = *(const LAS f32x4*)xr, x1 = *(const LAS f32x4*)(xr + 4);
                u32x4 pw; pw.x = pk2(x0[0], x0[1]); pw.y = pk2(x0[2], x0[3]); pw.z = pk2(x1[0], x1[1]); pw.w = pk2(x1[2], x1[3]);
                const bf16x8 af = __builtin_bit_cast(bf16x8, pw);
                ar = __builtin_amdgcn_mfma_f32_16x16x32_bf16(af, Ba[kk], ar, 0, 0, 0);
                ax = __builtin_amdgcn_mfma_f32_16x16x32_bf16(af, Bx[kk], ax, 0, 0, 0); }
            float P[4], H[4];
#pragma unroll
            for (int jj = 0; jj < 4; ++jj) { const int tok = 16 * m + 4 * g4 + jj;
                const float xc = XC[tok * 132 + chl];
                const float r = sigm(ar[jj] + bar), ig = sigm(ax[jj] + bxr);
                const float la = kch * r;
                const float a = __builtin_amdgcn_exp2f(la * 1.4426950408889634f);
                const float z = 2.0f * la;
                const float om = z > -4e-3f ? -z * (1.f + z * (0.5f + z * (1.f / 6.f))) : __builtin_fmaf(-a, a, 1.0f);
                const float b = __builtin_amdgcn_sqrtf(fmaxf(om, 0.f)) * (ig * xc);
                if (jj == 0) { P[0] = a; H[0] = b; } else { P[jj] = a * P[jj - 1]; H[jj] = a * H[jj - 1] + b; } }
            float Pt = P[3], Ht = H[3];
            float Pq = __shfl_up(Pt, 16), Hq = __shfl_up(Ht, 16); if (g4 >= 1) { Ht = Pt * Hq + Ht; Pt = Pt * Pq; }
            Pq = __shfl_up(Pt, 32); Hq = __shfl_up(Ht, 32); if (g4 >= 2) { Ht = Pt * Hq + Ht; Pt = Pt * Pq; }
            float Pe = __shfl_up(Pt, 16), He = __shfl_up(Ht, 16); if (g4 == 0) { Pe = 1.f; He = 0.f; }
            if constexpr (FINAL) {
                const float Hpre = Pe * Hc + He;
#pragma unroll
                for (int jj = 0; jj < 4; ++jj) HB[(16 * m + 4 * g4 + jj) * 132 + chl] = P[jj] * Hpre + H[jj];
            } else {
                const float Hpre = Pe * Hc + He, Ppre = Pe * Pc;
#pragma unroll
                for (int jj = 0; jj < 4; ++jj) { const unsigned hp = pk2(P[jj] * Hpre + H[jj], P[jj] * Ppre);
                    HL[(16 * m + 4 * g4 + jj) * 136 + chl] = (bf16_t)(hp & 0xffffu); PL[(16 * m + 4 * g4 + jj) * 136 + chl] = (bf16_t)(hp >> 16); }
            }
            const float Ptile = __shfl(Pt, r16 + 48), Htile = __shfl(Ht, r16 + 48);
            Hc = Ptile * Hc + Htile; Pc = Ptile * Pc;
        }
        if constexpr (!FINAL) { if (g4 == 0) { Atot[chunk * DLRU + ch] = Pc; Hend[chunk * DLRU + ch] = Hc; } }
        __syncthreads();
        if constexpr (!FINAL) {
            const size_t go = (size_t)(t0 + etok) * DLRU + n * 128 + ec16;
            const u32x4 h0 = *(const LAS u32x4*)(HL + etok * 136 + ec16), h1 = *(const LAS u32x4*)(HL + etok * 136 + ec16 + 8);
            const u32x4 p0 = *(const LAS u32x4*)(PL + etok * 136 + ec16), p1 = *(const LAS u32x4*)(PL + etok * 136 + ec16 + 8);
            *(u32x4*)(hlocB + go) = h0; *(u32x4*)(hlocB + go + 8) = h1; *(u32x4*)(pcumB + go) = p0; *(u32x4*)(pcumB + go + 8) = p1;
        }
        if constexpr (FINAL) {
            const LAS float* hr = HB + etok * 132 + ec16;
            float hv[16], g[16];
#pragma unroll
            for (int q = 0; q < 4; ++q) { const f32x4 v = *(const LAS f32x4*)(hr + 4 * q); hv[4 * q] = v[0]; hv[4 * q + 1] = v[1]; hv[4 * q + 2] = v[2]; hv[4 * q + 3] = v[3]; }
#pragma unroll
            for (int q = 0; q < 4; ++q) { g[2 * q] = bf_lo(gq0[q]); g[2 * q + 1] = bf_hi(gq0[q]); g[8 + 2 * q] = bf_lo(gq1[q]); g[8 + 2 * q + 1] = bf_hi(gq1[q]); }
            float o[16];
#pragma unroll
            for (int j = 0; j < 16; ++j) { const float u = 0.7978845608028654f * (g[j] + 0.044715f * g[j] * g[j] * g[j]); o[j] = hv[j] * g[j] * sigm(2.0f * u); }
            u32x4 w0, w1;
#pragma unroll
            for (int q = 0; q < 4; ++q) { w0[q] = pk2(o[2 * q], o[2 * q + 1]); w1[q] = pk2(o[8 + 2 * q], o[8 + 2 * q + 1]); }
            bf16_t* yo = Y + (size_t)(t0 + etok) * D_ + n * 128 + ec16;
            *(u32x4*)yo = w0; *(u32x4*)(yo + 8) = w1;
        }
        if (hc) t_store(cd, lane, cv, cs0, cs1, cscr);
    }
}

__device__ __forceinline__ void rope8(const u32x4 a, const u32x4 b, const f32x4 c0, const f32x4 c1, const f32x4 s0, const f32x4 s1, float scale, u32x4& oa, u32x4& ob) {
    float x1[8], x2[8], c[8], s[8], o1[8], o2[8];
#pragma unroll
    for (int i = 0; i < 4; ++i) { x1[2 * i] = bf_lo(a[i]); x1[2 * i + 1] = bf_hi(a[i]); x2[2 * i] = bf_lo(b[i]); x2[2 * i + 1] = bf_hi(b[i]); c[i] = c0[i]; c[4 + i] = c1[i]; s[i] = s0[i]; s[4 + i] = s1[i]; }
#pragma unroll
    for (int i = 0; i < 8; ++i) { o1[i] = (x1[i] * c[i] - x2[i] * s[i]) * scale; o2[i] = (x1[i] * s[i] + x2[i] * c[i]) * scale; }
#pragma unroll
    for (int i = 0; i < 4; ++i) { oa[i] = pk2(o1[2 * i], o1[2 * i + 1]); ob[i] = pk2(o2[2 * i], o2[2 * i + 1]); }
}
struct RopeC { float hi[16], lo[16]; };
__device__ __forceinline__ void rope_init(RopeC& R, int g4) {
#pragma unroll
    for (int j = 0; j < 16; ++j) { const int f = 32 * (j >> 3) + 8 * g4 + (j & 7);
        const double c = exp2(-(double)f * (13.287712379549449 / 64.0)) * 0.15915494309189535;
        const float hh = (float)c; R.hi[j] = hh; R.lo[j] = (float)(c - (double)hh); }
}
template <int K2>
__device__ __forceinline__ void rope_cs(const RopeC& R, float tpos, f32x4& c0, f32x4& c1, f32x4& s0, f32x4& s1) {
#pragma unroll
    for (int i = 0; i < 8; ++i) { const float hh = R.hi[K2 * 8 + i], p = tpos * hh, e = __builtin_fmaf(tpos, hh, -p);
        const float r = __builtin_amdgcn_fractf(p) + (e + tpos * R.lo[K2 * 8 + i]);
        const float cv = __builtin_amdgcn_cosf(r), sv = __builtin_amdgcn_sinf(r);
        if (i < 4) { c0[i] = cv; s0[i] = sv; } else { c1[i - 4] = cv; s1[i - 4] = sv; } }
}
__device__ __forceinline__ float log2gamma(int h) { return log1pf(-exp2f(-5.0f - (float)h)) * 1.4426950408889634f; }

__device__ __forceinline__ void p2_ret(Ctx& F) {
    const bf16_t* proj = (const bf16_t*)(F.ws + WS_PROJ);
    bf16_t* kvT = (bf16_t*)(F.ws + WS_KV);
    LAS bf16_t* KT = (LAS bf16_t*)F.lds;
    LAS bf16_t* VT = (LAS bf16_t*)(F.lds + 34816);
    const int w = F.wave, lane = F.lane, r16 = lane & 15, g4 = lane >> 4;
    const int tl = 16 * w + r16;
    RopeC RC; rope_init(RC, g4);
    u32x4 kc[4], vc[4];
#pragma unroll
    for (int kk = 0; kk < 4; ++kk) { kc[kk] = (u32x4){0u, 0u, 0u, 0u}; vc[kk] = kc[kk]; }
    if (F.bid < NRCH * 8) { const bf16_t* prow = proj + (size_t)((F.bid >> 3) * RCH + tl) * DIN + (F.bid & 7) * 128 + 8 * g4;
#pragma unroll
        for (int kk = 0; kk < 4; ++kk) { kc[kk] = *(const u32x4*)(prow + 3072 + 32 * kk); vc[kk] = *(const u32x4*)(prow + 4096 + 32 * kk); } }
    for (int it = F.bid; it < NRCH * 8; it += F.G) {
        const int h = it & 7, n = it >> 3, t0 = n * RCH;
        const float lg2 = log2gamma(h);
        u32x4 kr[4];
        { f32x4 c0, c1, s0, s1; const float tpos = (float)(t0 + tl);
          rope_cs<0>(RC, tpos, c0, c1, s0, s1); rope8(kc[0], kc[2], c0, c1, s0, s1, 0.08838834764831845f, kr[0], kr[2]);
          rope_cs<1>(RC, tpos, c0, c1, s0, s1); rope8(kc[1], kc[3], c0, c1, s0, s1, 0.08838834764831845f, kr[1], kr[3]); }
        const float zeta = __builtin_amdgcn_exp2f((float)(127 - tl) * lg2);
#pragma unroll
        for (int kk = 0; kk < 4; ++kk)
#pragma unroll
            for (int i = 0; i < 4; ++i) { const int d = 32 * kk + 8 * g4 + 2 * i;
                KT[d * 136 + tl] = (bf16_t)(kr[kk][i] & 0xffffu); KT[(d + 1) * 136 + tl] = (bf16_t)(kr[kk][i] >> 16);
                const unsigned vz = pk2(bf_lo(vc[kk][i]) * zeta, bf_hi(vc[kk][i]) * zeta);
                VT[d * 136 + tl] = (bf16_t)(vz & 0xffffu); VT[(d + 1) * 136 + tl] = (bf16_t)(vz >> 16); }
        __syncthreads();
        { const int itn = it + F.G;
          if (itn < NRCH * 8) { const bf16_t* prow = proj + (size_t)((itn >> 3) * RCH + tl) * DIN + (itn & 7) * 128 + 8 * g4;
#pragma unroll
            for (int kk = 0; kk < 4; ++kk) { kc[kk] = *(const u32x4*)(prow + 3072 + 32 * kk); vc[kk] = *(const u32x4*)(prow + 4096 + 32 * kk); } } }
        bf16x8 af[4];
#pragma unroll
        for (int kk = 0; kk < 4; ++kk) af[kk] = *(const LAS bf16x8*)(KT + (16 * w + r16) * 136 + 32 * kk + 8 * g4);
        bf16_t* dst = kvT + ((size_t)(n * 8 + h) * 128 + r16) * 128 + 16 * w + 4 * g4;
#pragma unroll
        for (int ne = 0; ne < 8; ++ne) { f32x4 acc = (f32x4){0.f, 0.f, 0.f, 0.f};
#pragma unroll
            for (int kk = 0; kk < 4; ++kk) { const bf16x8 bfr = *(const LAS bf16x8*)(VT + (16 * ne + r16) * 136 + 32 * kk + 8 * g4); acc = __builtin_amdgcn_mfma_f32_16x16x32_bf16(af[kk], bfr, acc, 0, 0, 0); }
            u32x2 o; o.x = pk2_sw(acc[0], acc[1]); o.y = pk2_sw(acc[2], acc[3]);
            *(u32x2*)(dst + (size_t)(16 * ne) * 128) = o; }
        __syncthreads();
    }
}

__device__ __forceinline__ void p3_carries(Ctx& F) {
    const int gw = F.wave * F.G + F.bid, NGW = F.G * NWAVES, lane = F.lane;
    const bf16_t* kvT = (const bf16_t*)(F.ws + WS_KV); bf16_t* Rp = (bf16_t*)(F.ws + WS_RP);
    const float* Atot = (const float*)(F.ws + WS_ATOT); const float* Hend = (const float*)(F.ws + WS_HEND); float* carry = (float*)(F.ws + WS_CARRY);
    constexpr int NRT = 8 * 128 * 128 / 128;
    constexpr int NLT = DLRU / 8;
    for (int task = gw; task < NRT + NLT; task += NGW) {
        if (task < NRT) {
            const int e2 = task * 128 + 2 * lane, h = e2 >> 14;
            const float gC = exp2f(128.0f * log2gamma(h));
            unsigned kv[NRCH];
#pragma unroll
            for (int j = 0; j < NRCH; ++j) kv[j] = __builtin_nontemporal_load((const unsigned*)(kvT + (size_t)j * 131072 + e2));
            float r0 = 0.f, r1 = 0.f;
#pragma unroll
            for (int j = 0; j < NRCH; ++j) { *(unsigned*)(Rp + (size_t)j * 131072 + e2) = pk2(r0, r1); r0 = r0 * gC + bf_lo(kv[j]); r1 = r1 * gC + bf_hi(kv[j]); }
        } else {
            const int ch = (task - NRT) * 8 + (lane & 7), seg = lane >> 3, c0 = seg * 16;
            float av[16], hv[16];
#pragma unroll
            for (int j = 0; j < 16; ++j) { av[j] = Atot[(c0 + j) * DLRU + ch]; hv[j] = Hend[(c0 + j) * DLRU + ch]; }
            float A = 1.f, H = 0.f;
#pragma unroll
            for (int j = 0; j < 16; ++j) { H = av[j] * H + hv[j]; A = av[j] * A; }
#pragma unroll
            for (int o = 8; o < 64; o <<= 1) { const float Ap = __shfl_up(A, o), Hp = __shfl_up(H, o); if (lane >= o) { H = A * Hp + H; A = A * Ap; } }
            float Hc = __shfl_up(H, 8); if (seg == 0) Hc = 0.f;
#pragma unroll
            for (int j = 0; j < 16; ++j) { carry[(c0 + j) * DLRU + ch] = Hc; Hc = av[j] * Hc + hv[j]; }
        }
    }
}

__device__ __forceinline__ void p4_ret_preload(Ctx& F, u32x4 (&qc)[4], u32x4 (&kc)[4], u32x4 (&vc)[4], u32x4 (&gq)[4]) {
    const bf16_t* proj = (const bf16_t*)(F.ws + WS_PROJ);
    const int w = F.wave, lane = F.lane, r16 = lane & 15, g4 = lane >> 4, orow = lane >> 2, ocol = (lane & 3) * 32, tl = 16 * w + r16;
#pragma unroll
    for (int kk = 0; kk < 4; ++kk) { qc[kk] = (u32x4){0u, 0u, 0u, 0u}; kc[kk] = qc[kk]; vc[kk] = qc[kk]; gq[kk] = qc[kk]; }
    if (F.bid < NRCH * 8) { const int h0 = F.bid & 7, tb = (F.bid >> 3) * RCH;
        const bf16_t* prow = proj + (size_t)(tb + tl) * DIN + h0 * 128 + 8 * g4;
#pragma unroll
        for (int kk = 0; kk < 4; ++kk) { qc[kk] = __builtin_nontemporal_load((const u32x4*)(prow + 2048 + 32 * kk)); kc[kk] = __builtin_nontemporal_load((const u32x4*)(prow + 3072 + 32 * kk)); vc[kk] = __builtin_nontemporal_load((const u32x4*)(prow + 4096 + 32 * kk)); }
        const bf16_t* gp = proj + (size_t)(tb + 16 * w + orow) * DIN + 5120 + h0 * 128 + ocol;
#pragma unroll
        for (int i = 0; i < 4; ++i) gq[i] = __builtin_nontemporal_load((const u32x4*)(gp + 8 * i)); }
}
__device__ __forceinline__ void p4_ret(Ctx& F, u32x4 (&qc)[4], u32x4 (&kc)[4], u32x4 (&vc)[4], u32x4 (&gq)[4]) {
    const bf16_t* proj = (const bf16_t*)(F.ws + WS_PROJ); bf16_t* Y = (bf16_t*)(F.ws + WS_Y);
    const bf16_t* Rp = (const bf16_t*)(F.ws + WS_RP);
    LAS bf16_t* KS = (LAS bf16_t*)F.lds;
    LAS bf16_t* VT = (LAS bf16_t*)(F.lds + 34816);
    LAS unsigned char* RL = F.lds + 104448;
    const int w = F.wave, lane = F.lane, r16 = lane & 15, g4 = lane >> 4;
    LAS bf16_t* PS = (LAS bf16_t*)(F.lds + 69632) + w * (16 * 136);
    const int orow = lane >> 2, ocol = (lane & 3) * 32;
    const int tl = 16 * w + r16;
    RopeC RC; rope_init(RC, g4);
    for (int it = F.bid; it < NRCH * 8; it += F.G) {
        const int h = it & 7, n = it >> 3, t0 = n * RCH;
        const float lg2 = log2gamma(h);
        { const char* rg = (const char*)(Rp + (size_t)(n * 8 + h) * 16384);
#pragma unroll
          for (int i = 0; i < 4; ++i) { const int e = i * 32 + w * 4 + (lane >> 4), pos = lane & 15;
              __builtin_amdgcn_global_load_lds((const unsigned*)(rg + e * 256 + ((pos ^ (e & 15)) * 16)), (LAS unsigned*)(RL + i * 8192 + w * 1024), 16, 0, 0); } }
        u32x4 qf[4], go[4];
        {
            u32x4 kr[4];
            { f32x4 c0, c1, s0, s1; const float tpos = (float)(t0 + tl);
              rope_cs<0>(RC, tpos, c0, c1, s0, s1); rope8(qc[0], qc[2], c0, c1, s0, s1, 1.0f, qf[0], qf[2]); rope8(kc[0], kc[2], c0, c1, s0, s1, 0.08838834764831845f, kr[0], kr[2]);
              rope_cs<1>(RC, tpos, c0, c1, s0, s1); rope8(qc[1], qc[3], c0, c1, s0, s1, 1.0f, qf[1], qf[3]); rope8(kc[1], kc[3], c0, c1, s0, s1, 0.08838834764831845f, kr[1], kr[3]); }
#pragma unroll
            for (int kk = 0; kk < 4; ++kk) { *(LAS u32x4*)(KS + tl * 136 + 32 * kk + 8 * g4) = kr[kk];
#pragma unroll
                for (int i = 0; i < 4; ++i) { const int e = 32 * kk + 8 * g4 + 2 * i; VT[e * 136 + tl] = (bf16_t)(vc[kk][i] & 0xffffu); VT[(e + 1) * 136 + tl] = (bf16_t)(vc[kk][i] >> 16); } }
#pragma unroll
            for (int i = 0; i < 4; ++i) go[i] = gq[i];
        }
        asm volatile("s_waitcnt vmcnt(0)" ::: "memory");
        __syncthreads();
        { const int itn = it + F.G;
          if (itn < NRCH * 8) { const int hn = itn & 7, tb = (itn >> 3) * RCH;
            const bf16_t* prow = proj + (size_t)(tb + tl) * DIN + hn * 128 + 8 * g4;
#pragma unroll
            for (int kk = 0; kk < 4; ++kk) { qc[kk] = __builtin_nontemporal_load((const u32x4*)(prow + 2048 + 32 * kk)); kc[kk] = __builtin_nontemporal_load((const u32x4*)(prow + 3072 + 32 * kk)); vc[kk] = __builtin_nontemporal_load((const u32x4*)(prow + 4096 + 32 * kk)); }
            const bf16_t* gp = proj + (size_t)(tb + 16 * w + orow) * DIN + 5120 + hn * 128 + ocol;
#pragma unroll
            for (int i = 0; i < 4; ++i) gq[i] = __builtin_nontemporal_load((const u32x4*)(gp + 8 * i)); } }
#pragma unroll
        for (int nn = 0; nn < 8; ++nn) {
            if (nn <= w) {
                f32x4 acc = (f32x4){0.f, 0.f, 0.f, 0.f};
#pragma unroll
                for (int kk = 0; kk < 4; ++kk) { const bf16x8 kf = *(const LAS bf16x8*)(KS + (16 * nn + r16) * 136 + 32 * kk + 8 * g4); acc = __builtin_amdgcn_mfma_f32_16x16x32_bf16(__builtin_bit_cast(bf16x8, qf[kk]), kf, acc, 0, 0, 0); }
#pragma unroll
                for (int jj = 0; jj < 4; ++jj) { const int diff = (16 * w + 4 * g4 + jj) - (16 * nn + r16);
                    const float p = diff >= 0 ? acc[jj] * __builtin_amdgcn_exp2f((float)diff * lg2) : 0.f;
                    PS[(4 * g4 + jj) * 136 + 16 * nn + r16] = (bf16_t)(pk2(p, 0.f) & 0xffffu); }
            } else if (nn <= (w | 1)) {
#pragma unroll
                for (int jj = 0; jj < 4; ++jj) PS[(4 * g4 + jj) * 136 + 16 * nn + r16] = (bf16_t)0;
            }
        }
        asm volatile("s_waitcnt lgkmcnt(0)" ::: "memory");
        f32x4 O[8];
#pragma unroll
        for (int ne = 0; ne < 8; ++ne) O[ne] = (f32x4){0.f, 0.f, 0.f, 0.f};
#pragma unroll
        for (int k2 = 0; k2 < 4; ++k2) {
            if (k2 <= (w >> 1)) {
                const bf16x8 pf = *(const LAS bf16x8*)(PS + r16 * 136 + 32 * k2 + 8 * g4);
#pragma unroll
                for (int ne = 0; ne < 8; ++ne) { const bf16x8 vf = *(const LAS bf16x8*)(VT + (16 * ne + r16) * 136 + 32 * k2 + 8 * g4); O[ne] = __builtin_amdgcn_mfma_f32_16x16x32_bf16(pf, vf, O[ne], 0, 0, 0); }
            }
        }
        float xi[4];
#pragma unroll
        for (int jj = 0; jj < 4; ++jj) xi[jj] = __builtin_amdgcn_exp2f((float)(16 * w + 4 * g4 + jj + 1) * lg2);
#pragma unroll
        for (int ne = 0; ne < 8; ++ne) { f32x4 cx = (f32x4){0.f, 0.f, 0.f, 0.f};
#pragma unroll
            for (int kk = 0; kk < 4; ++kk) { const bf16x8 rf = *(const LAS bf16x8*)(RL + (16 * ne + r16) * 256 + (((4 * kk + g4) ^ r16) * 16)); cx = __builtin_amdgcn_mfma_f32_16x16x32_bf16(__builtin_bit_cast(bf16x8, qf[kk]), rf, cx, 0, 0, 0); }
#pragma unroll
            for (int jj = 0; jj < 4; ++jj) O[ne][jj] += xi[jj] * cx[jj]; }
        float gnw[8];
#pragma unroll
        for (int ne = 0; ne < 8; ++ne) gnw[ne] = F.gn_w[h * 128 + 16 * ne + r16];
#pragma unroll
        for (int jj = 0; jj < 4; ++jj) {
            float s = 0.f;
#pragma unroll
            for (int ne = 0; ne < 8; ++ne) s += O[ne][jj];
            s += __shfl_xor(s, 1); s += __shfl_xor(s, 2); s += __shfl_xor(s, 4); s += __shfl_xor(s, 8);
            const float mu = s * (1.0f / 128.0f); float q = 0.f;
#pragma unroll
            for (int ne = 0; ne < 8; ++ne) { const float d = O[ne][jj] - mu; q += d * d; }
            q += __shfl_xor(q, 1); q += __shfl_xor(q, 2); q += __shfl_xor(q, 4); q += __shfl_xor(q, 8);
            const float rstd = __builtin_amdgcn_rsqf(q * (1.0f / 128.0f) + EPS);
#pragma unroll
            for (int ne = 0; ne < 8; ++ne) { const float on = (O[ne][jj] - mu) * rstd * gnw[ne];
                PS[(4 * g4 + jj) * 136 + 16 * ne + r16] = (bf16_t)(pk2(on, 0.f) & 0xffffu); }
        }
        asm volatile("s_waitcnt lgkmcnt(0)" ::: "memory");
        { bf16_t* yo = Y + (size_t)(t0 + 16 * w + orow) * D_ + DLRU + h * 128 + ocol;
#pragma unroll
          for (int i = 0; i < 4; ++i) { const u32x4 ov = *(const LAS u32x4*)(PS + orow * 136 + ocol + 8 * i); u32x4 wv;
#pragma unroll
              for (int j = 0; j < 4; ++j) { const float g0 = bf_lo(go[i][j]), g1 = bf_hi(go[i][j]); wv[j] = pk2(bf_lo(ov[j]) * (g0 * sigm(g0)), bf_hi(ov[j]) * (g1 * sigm(g1))); }
              *(u32x4*)(yo + 8 * i) = wv; } }
        __syncthreads();
    }
}

__device__ __forceinline__ void p4_lru_fix(Ctx& F) {
    const bf16_t* proj = (const bf16_t*)(F.ws + WS_PROJ); bf16_t* Y = (bf16_t*)(F.ws + WS_Y);
    const bf16_t* hlocB = (const bf16_t*)F.out + (size_t)S_ * D_; const bf16_t* pcumB = hlocB + (size_t)S_ * DLRU;
    const float* carry = (const float*)(F.ws + WS_CARRY);
    for (int i = F.bid * NTHR + F.tid; i < S_ * (DLRU / 8); i += F.G * NTHR) {
        const int t = i >> 7, c = (i & 127) * 8;
        const u32x4 hl = __builtin_nontemporal_load((const u32x4*)(hlocB + (size_t)t * DLRU + c)), pc = __builtin_nontemporal_load((const u32x4*)(pcumB + (size_t)t * DLRU + c)), gw = __builtin_nontemporal_load((const u32x4*)(proj + (size_t)t * DIN + DLRU + c));
        const float* cp = carry + (size_t)(t >> 6) * DLRU + c; const f32x4 c0 = *(const f32x4*)cp, c1 = *(const f32x4*)(cp + 4);
        u32x4 o;
#pragma unroll
        for (int q = 0; q < 4; ++q) { const float ca = q < 2 ? c0[2 * q] : c1[2 * q - 4], cb = q < 2 ? c0[2 * q + 1] : c1[2 * q - 3];
            const float ha = bf_lo(hl[q]) + bf_lo(pc[q]) * ca, hb = bf_hi(hl[q]) + bf_hi(pc[q]) * cb, ga = bf_lo(gw[q]), gb = bf_hi(gw[q]);
            const float ua = 0.7978845608028654f * (ga + 0.044715f * ga * ga * ga), ub = 0.7978845608028654f * (gb + 0.044715f * gb * gb * gb);
            o[q] = pk2(ha * ga * sigm(2.0f * ua), hb * gb * sigm(2.0f * ub)); }
        *(u32x4*)(Y + (size_t)t * D_ + c) = o;
    }
}

__device__ __forceinline__ void p8_final(Ctx& F) {
    const int gw = F.bid * NWAVES + F.wave, NGW = F.G * NWAVES;
    const float* ss3 = (const float*)(F.ws + WS_SS3);
    for (int m = gw; m < S_; m += NGW) {
        const f32x4 p0 = *(const f32x4*)(ss3 + (size_t)m * 8), p1 = *(const f32x4*)(ss3 + (size_t)m * 8 + 4);
        const float tot = ((p0[0] + p0[1]) + (p0[2] + p0[3])) + ((p1[0] + p1[1]) + (p1[2] + p1[3]));
        const float rstd = 1.0f / sqrtf(tot * (1.0f / D_) + EPS);
        f32x4* xr = (f32x4*)(F.out + (size_t)m * D_) + F.lane; const f32x4* wr = (const f32x4*)F.fnw + F.lane;
#pragma unroll
        for (int j = 0; j < 8; ++j) { const f32x4 v = xr[64 * j], wv = wr[64 * j]; xr[64 * j] = v * rstd * wv; }
    }
}

__global__ void __launch_bounds__(NTHR, 2) hymba_fwd(Args args) {
    extern __shared__ __attribute__((aligned(16))) unsigned char lds_raw[];
    Ctx F;
    F.lds = (LAS unsigned char*)lds_raw;
    F.tid = threadIdx.x; F.lane = F.tid & 63; F.wave = __builtin_amdgcn_readfirstlane(F.tid >> 6); F.G = gridDim.x; F.bid = blockIdx.x;
    F.x = args.in[0]; F.ln1 = args.in[1]; F.w_in = args.in[2]; F.conv_w = args.in[3]; F.conv_b = args.in[4]; F.ga_w = args.in[5]; F.ga_b = args.in[6]; F.gx_w = args.in[7];
    F.gx_b = args.in[8]; F.lam = args.in[9]; F.gn_w = args.in[10]; F.w_out = args.in[11]; F.ln2 = args.in[12]; F.w_g = args.in[13]; F.w_u = args.in[14]; F.w_d = args.in[15]; F.fnw = args.in[16];
    F.out = args.out; F.ws = args.ws;
    const int lo = args.ph_lo, hi = args.ph_hi;
#define IN(k) (lo <= (k) && (k) < hi)
#define SEAM(k) do { if (IN(k) && IN((k) + 1)) { xcd_barrier(bar); } } while (0)
    unsigned char* ws = args.ws;
    XcdBarrier bar; bar.bar = (unsigned*)(ws + WS_BAR); bar.x = 0; bar.st = (volatile LAS unsigned*)(F.lds + LDS_CTL);
    if (hi - lo > 1) {
        if (F.tid < 4) ((LAS unsigned*)(F.lds + LDS_CTL))[F.tid] = 0u;
        __syncthreads();
        bar = xcd_barrier_post((unsigned*)(ws + WS_BAR), (volatile LAS unsigned*)(F.lds + LDS_CTL));
    }
    if (lo == 12345) cg::this_grid().sync();

    if (IN(0)) { p0_prologue(F, 0, F.bid * NWAVES + F.wave, F.G * NWAVES); }
    SEAM(0);
    if (IN(1)) {
        pg8::Gemm g{(const bf16_t*)F.out, (const bf16_t*)(ws + WS_WIN), S_, DIN, D_}; pg8::StaticOrder S; S.init(S_, DIN, F.G, F.bid);
        pg8::EpiProj E{(bf16_t*)(ws + WS_PROJ), DIN, (const float*)(ws + WS_RSTD1)};
        pg8::gemm_phase<pg8::EpiProj, pg8::StaticOrder, true, true>(F.lds, g, S, E);
        if (REP_MASK & 2) pg8::gemm_phase<pg8::EpiProj, pg8::StaticOrder, true, true>(F.lds, g, S, E);
    }
    SEAM(1);
    if (IN(2)) { p2_lru<false>(F, 1, F.bid * NWAVES + F.wave, F.G * NWAVES, 4);   p2_ret(F); }
    SEAM(2);
    u32x4 pq[4], pk[4], pv[4], pg[4];
    if (IN(3)) { p4_ret_preload(F, pq, pk, pv, pg); p3_carries(F); }
    SEAM(3);
    if (IN(4)) { if (!IN(3)) p4_ret_preload(F, pq, pk, pv, pg); p4_ret(F, pq, pk, pv, pg);
        p4_lru_fix(F);
        p0_prologue(F, 1, (F.bid + 4 * F.G) * NWAVES + F.wave, F.G * NWAVES); }
    SEAM(4);
    if (IN(5)) {
        pg8::Gemm g{(const bf16_t*)(ws + WS_Y), (const bf16_t*)(ws + WS_WOUT), S_, D_, D_}; pg8::StaticOrder S; S.init(S_, D_, F.G, F.bid);
        pg8::EpiResid E{(const bf16_t*)F.out, nullptr, (bf16_t*)(ws + WS_H1B), D_, (float*)(ws + WS_SS2)};
        pg8::gemm_phase<pg8::EpiResid, pg8::StaticOrder, false, true>(F.lds, g, S, E);
        if (REP_MASK & 32) pg8::gemm_phase<pg8::EpiResid, pg8::StaticOrder, false, true>(F.lds, g, S, E);
    }
    SEAM(5);
    if (IN(6)) {
        pg8::Gemm g{(const bf16_t*)(ws + WS_H1B), (const bf16_t*)(ws + WS_WGU), S_, NGU, D_}; pg8::StaticOrder S; S.init(S_, NGU, F.G, F.bid);
        pg8::EpiSwiglu E{(bf16_t*)(ws + WS_FF), DFF, (const float*)(ws + WS_SS2)};
        pg8::gemm_phase<pg8::EpiSwiglu, pg8::StaticOrder, true, true>(F.lds, g, S, E);
        if (REP_MASK & 64) pg8::gemm_phase<pg8::EpiSwiglu, pg8::StaticOrder, true, true>(F.lds, g, S, E);
        const int nun = (S_ / 256) * (NGU / 256), full = nun / F.G, rem = nun % F.G;
        if (rem == 0) p0_prologue(F, 2, F.bid * NWAVES + F.wave, F.G * NWAVES);
        else if (F.bid >= rem) p0_prologue(F, 2, (F.bid - rem) * NWAVES + F.wave, (F.G - rem) * NWAVES);
        (void)full;
    }
    SEAM(6);
    if (IN(7)) {
        pg8::Gemm g{(const bf16_t*)(ws + WS_FF), (const bf16_t*)(ws + WS_WD), S_, D_, DFF}; pg8::StaticOrder S; S.init(S_, D_, F.G, F.bid);
        if (REP_MASK & 128) { pg8::EpiNull E{(float*)(ws + WS_SS2)}; pg8::gemm_phase<pg8::EpiNull, pg8::StaticOrder, false, true>(F.lds, g, S, E); }
        if (hi - lo > 1) {
            pg8::EpiFinal E{(const bf16_t*)(ws + WS_H1B), F.out, D_, (float*)(ws + WS_SS3), (unsigned*)(ws + WS_PCNT), F.fnw, (unsigned*)(ws + WS_PCNT + 32 * 256)};
            pg8::gemm_phase<pg8::EpiFinal, pg8::StaticOrder, false, true>(F.lds, g, S, E);
        } else {
            pg8::EpiResid E{(const bf16_t*)(ws + WS_H1B), F.out, nullptr, D_, (float*)(ws + WS_SS3)};
            pg8::gemm_phase<pg8::EpiResid, pg8::StaticOrder, false, true>(F.lds, g, S, E);
        }
    }
    if (hi - lo <= 1) { if (IN(8)) { p8_final(F); } }
#undef IN
#undef SEAM
}

extern "C" void kernel_launch(void* const* d_in, const int* in_sizes, int n_in, void* d_out, int out_size, void* d_ws, size_t ws_size, hipStream_t stream) {
    static int grid = 0;
    if (grid == 0) {
        if (n_in != 17 || out_size != S_ * D_ || ws_size < WS_END) { fprintf(stderr, "kernel_launch: unexpected shapes: n_in %d out %d ws %zu (need %zu)\n", n_in, out_size, ws_size, (size_t)WS_END); grid = -1; return; }
        int dev = 0, cus = 0, per_cu = 0;
        (void)hipGetDevice(&dev); (void)hipDeviceGetAttribute(&cus, hipDeviceAttributeMultiprocessorCount, dev);
        if (hipFuncSetAttribute((const void*)hymba_fwd, hipFuncAttributeMaxDynamicSharedMemorySize, LDS_BYTES) != hipSuccess) { fprintf(stderr, "kernel_launch: hipFuncSetAttribute failed\n"); grid = -1; return; }
        (void)hipOccupancyMaxActiveBlocksPerMultiprocessor(&per_cu, (const void*)hymba_fwd, NTHR, LDS_BYTES);
        (void)hipGetLastError();
        if (per_cu < 1) { fprintf(stderr, "kernel_launch: occupancy query says %d blocks per CU\n", per_cu); per_cu = 1; }
        grid = cus;
        if (grid != 256) fprintf(stderr, "kernel_launch: grid %d != 256: the residual GEMM phases need one unit per workgroup\n", grid);
    }
    if (grid < 0) return;
    Args a{};
    for (int i = 0; i < 17; ++i) a.in[i] = (const float*)d_in[i];
    a.out = (float*)d_out; a.ws = (unsigned char*)d_ws;
#if MK_ONE_LAUNCH
    if (hipMemsetAsync((char*)d_ws + WS_BAR, 0, CTL_ZERO_BYTES, stream) != hipSuccess) { fprintf(stderr, "kernel_launch: memset of barrier words failed\n"); return; }
    a.ph_lo = 0; a.ph_hi = 9;
    void* kargs[] = {&a};
    hipError_t e = hipLaunchCooperativeKernel((const void*)hymba_fwd, dim3(grid), dim3(NTHR), kargs, LDS_BYTES, stream);
    if (e != hipSuccess) fprintf(stderr, "kernel_launch: cooperative launch failed: %s (grid %d)\n", hipGetErrorString(e), grid);
#else
    for (int p = 0; p < 9; ++p) { a.ph_lo = p; a.ph_hi = p + 1; hipLaunchKernelGGL(hymba_fwd, dim3(grid), dim3(NTHR), LDS_BYTES, stream, a); }
#endif
}
```
